# Optimizing an MI355X kernel written in HIP

```python
import math
import jax, jax.numpy as jnp
from jax import lax
import numpy as np

D_MODEL = 1024
BATCH = 4
SEQ = 4096
DEPTH = 2

D_RNN = 1024
RNN_BLOCKS = 4
RNN_BW = D_RNN // RNN_BLOCKS
CONV_W = 4
LRU_C = 8.0
ATT_GROUPS = ((128, 1), (512, 4), (2048, 16))
N_GROUPS = len(ATT_GROUPS)
ATT_HEADS = 8
ATT_HEAD_DIM = 64
ATT_W = ATT_HEADS * ATT_HEAD_DIM
ATT_BLOCK = 128
OFF_XR = 0
OFF_YR = OFF_XR + D_RNN
OFF_Q = OFF_YR + D_RNN
OFF_K = OFF_Q + N_GROUPS * ATT_W
OFF_V = OFF_K + N_GROUPS * ATT_W
OFF_GA = OFF_V + N_GROUPS * ATT_W
OFF_GB = OFF_GA + D_MODEL
N_IN = OFF_GB + D_MODEL
N_EXPERTS = 32
TOP_K = 4
D_FF = D_MODEL
SWIGLU_ALPHA = 1.702
SWIGLU_LIMIT = 7.0
MOE_BLOCK = 128
PLE_DIM = 256
ALPHA = (2.0 * DEPTH) ** 0.25
BETA = (8.0 * DEPTH) ** -0.25
LN_EPS = 1e-5

kernel_name = 'hybrid_rglru_dilated_attn_moe_deepnorm'


def _layer_norm(x, g, b):
    xf = x.astype(jnp.float32)
    mu = jnp.mean(xf, axis=-1, keepdims=True)
    var = jnp.mean(jnp.square(xf - mu), axis=-1, keepdims=True)
    y = (xf - mu) * lax.rsqrt(var + LN_EPS)
    return (y * g.astype(jnp.float32) + b.astype(jnp.float32)).astype(x.dtype)


def _causal_conv(x, w, b):
    C = x.shape[-1]
    y = lax.conv_general_dilated(x, w[:, None, :].astype(x.dtype), window_strides=(1,),
                                 padding=((CONV_W - 1, 0),),
                                 dimension_numbers=('NWC', 'WIO', 'NWC'),
                                 feature_group_count=C)
    return y + b.astype(x.dtype)


def _rg_lru(xc, w_rg, b_rg, w_ig, b_ig, lam):
    B, S, C = xc.shape
    xf = xc.astype(jnp.float32)
    xb = xf.reshape(B, S, RNN_BLOCKS, RNN_BW)
    r = jax.nn.sigmoid(jnp.einsum('bsnc,ncd->bsnd', xb, w_rg.astype(jnp.float32)).reshape(B, S, C) + b_rg)
    i = jax.nn.sigmoid(jnp.einsum('bsnc,ncd->bsnd', xb, w_ig.astype(jnp.float32)).reshape(B, S, C) + b_ig)
    log_a = -LRU_C * r * jax.nn.softplus(-lam.astype(jnp.float32))
    a = jnp.exp(log_a)
    bx = jnp.sqrt(-jnp.expm1(2.0 * log_a)) * (i * xf)

    def combine(left, right):
        a1, b1 = left
        a2, b2 = right
        return a1 * a2, a2 * b1 + b2

    _, h = lax.associative_scan(combine, (a, bx), axis=1)
    return h.astype(xc.dtype)


def _dilated_window_attention(q, k, v, dilation, n_back):
    B, S, H, Dh = q.shape
    L = S // dilation
    nb = -(-L // ATT_BLOCK)
    Lp = nb * ATT_BLOCK

    def split(t):
        t = t.reshape(B, L, dilation, H, Dh).transpose(0, 2, 1, 3, 4).reshape(B * dilation, L, H, Dh)
        t = jnp.pad(t, ((0, 0), (0, Lp - L), (0, 0), (0, 0)))
        return t.reshape(B * dilation, nb, ATT_BLOCK, H, Dh)

    def with_prev(t):
        prev = jnp.pad(t[:, :-1], ((0, 0), (1, 0), (0, 0), (0, 0), (0, 0)))
        return jnp.concatenate([prev, t], axis=2)

    qb = split(q)
    kw = with_prev(split(k))
    vw = with_prev(split(v))
    s = jnp.einsum('bnqhd,bnkhd->bnhqk', qb, kw,
                   preferred_element_type=jnp.float32) * (Dh ** -0.5)
    qi = jnp.arange(ATT_BLOCK)[:, None]
    kj = jnp.arange(2 * ATT_BLOCK)[None, :]
    diff = ATT_BLOCK + qi - kj
    kpos = (jnp.arange(nb) * ATT_BLOCK - ATT_BLOCK)[:, None, None] + kj[None]
    valid = (diff >= 0)[None] & (diff <= n_back)[None] & (kpos >= 0)
    s = jnp.where(valid[None, :, None], s, -jnp.inf)
    lse = jax.nn.logsumexp(s, axis=-1)
    pr = jnp.exp(s - lse[..., None])
    o = jnp.einsum('bnhqk,bnkhd->bnqhd', pr.astype(vw.dtype), vw)
    o = o.reshape(B * dilation, Lp, H, Dh)[:, :L]
    o = o.reshape(B, dilation, L, H, Dh).transpose(0, 2, 1, 3, 4).reshape(B, S, H, Dh)
    lse = lse.transpose(0, 1, 3, 2).reshape(B * dilation, Lp, H)[:, :L]
    lse = lse.reshape(B, dilation, L, H).transpose(0, 2, 1, 3).reshape(B, S, H)
    return o, lse


def _mixer(u, w_in, conv_w, conv_b, w_rg, b_rg, w_ig, b_ig, lru_lambda, w_rnn_out, w_att_out, w_out):
    B, S, _ = u.shape
    z = u @ w_in
    xr, yr, q_all, k_all, v_all, ga, gb = jnp.split(
        z, [OFF_YR, OFF_Q, OFF_K, OFF_V, OFF_GA, OFF_GB], axis=-1)
    h = _rg_lru(_causal_conv(xr, conv_w, conv_b), w_rg, b_rg, w_ig, b_ig, lru_lambda)
    y_a = (jax.nn.gelu(yr) * h) @ w_rnn_out
    outs, lses = [], []
    for gi, (window, dil) in enumerate(ATT_GROUPS):
        sl = slice(gi * ATT_W, (gi + 1) * ATT_W)
        shp = (B, S, ATT_HEADS, ATT_HEAD_DIM)
        o, lse = _dilated_window_attention(q_all[..., sl].reshape(shp), k_all[..., sl].reshape(shp),
                                           v_all[..., sl].reshape(shp), dil, window // dil)
        outs.append(o)
        lses.append(lse)
    wts = jax.nn.softmax(jnp.stack(lses), axis=0)
    o = jnp.einsum('gbsh,gbshd->bshd', wts.astype(u.dtype), jnp.stack(outs))
    y_b = o.reshape(B, S, ATT_W) @ w_att_out
    merged = jax.nn.sigmoid(ga) * y_a + jax.nn.sigmoid(gb) * y_b
    return merged @ w_out


def _moe(x, w_router, b_router, w_gate, b_gate, w_up, b_up, w_down, b_down):
    B, S, D = x.shape
    T = B * S
    xt = x.reshape(T, D)
    logits = (xt @ w_router).astype(jnp.float32) + b_router.astype(jnp.float32)
    top_v, top_e = lax.top_k(logits, TOP_K)
    gates = jax.nn.softmax(top_v, axis=-1)
    flat_e = top_e.reshape(-1)
    flat_g = gates.reshape(-1)
    A = T * TOP_K
    order = jnp.argsort(flat_e)
    e_sorted = flat_e[order]
    counts = jnp.bincount(flat_e, length=N_EXPERTS)
    padded = (counts + MOE_BLOCK - 1) // MOE_BLOCK * MOE_BLOCK
    pend = jnp.cumsum(padded)
    pstart = pend - padded
    cstart = jnp.cumsum(counts) - counts
    dest = pstart[e_sorted] + (jnp.arange(A) - cstart[e_sorted])
    n_blk = -(-A // MOE_BLOCK) + N_EXPERTS
    P = n_blk * MOE_BLOCK
    buf_tok = jnp.zeros((P,), jnp.int32).at[dest].set((order // TOP_K).astype(jnp.int32))
    buf_w = jnp.zeros((P,), jnp.float32).at[dest].set(flat_g[order])
    blk_expert = jnp.minimum(jnp.searchsorted(pend, jnp.arange(n_blk) * MOE_BLOCK, side='right'),
                             N_EXPERTS - 1)
    xb = xt[buf_tok].reshape(n_blk, MOE_BLOCK, D)

    def expert_block(args):
        xe, e = args
        g = xe @ w_gate[e] + b_gate[e]
        up = xe @ w_up[e] + b_up[e]
        g = jnp.minimum(g, SWIGLU_LIMIT)
        up = jnp.clip(up, -SWIGLU_LIMIT, SWIGLU_LIMIT)
        hdn = (up + 1.0) * (g * jax.nn.sigmoid(SWIGLU_ALPHA * g))
        return hdn @ w_down[e] + b_down[e]

    yb = lax.map(expert_block, (xb, blk_expert)).reshape(P, D)
    y = jnp.zeros((T, D), jnp.float32).at[buf_tok].add(yb.astype(jnp.float32) * buf_w[:, None])
    return y.astype(x.dtype).reshape(B, S, D)


def setup_inputs(seed: int = 0) -> dict:
    key = jax.random.key(seed)
    ks = jax.random.split(key, 32)
    L = DEPTH
    nrm = lambda k, shape, scale: jax.random.normal(k, shape, jnp.float32) * scale
    col_scale = jnp.ones((N_IN,), jnp.float32).at[OFF_V:OFF_GA].set(BETA)
    u = jax.random.uniform(ks[10], (L, D_RNN), jnp.float32, 0.9, 0.999)
    s = u ** (1.0 / LRU_C)
    lru_lambda = jnp.log(s) - jnp.log1p(-s)
    return {
        'x': nrm(ks[0], (BATCH, SEQ, D_MODEL), 1.0),
        'p': nrm(ks[1], (DEPTH, BATCH, SEQ, PLE_DIM), 1.0),
        'w_in': nrm(ks[2], (L, D_MODEL, N_IN), D_MODEL ** -0.5) * col_scale,
        'conv_w': nrm(ks[3], (L, CONV_W, D_RNN), CONV_W ** -0.5),
        'conv_b': nrm(ks[4], (L, D_RNN), 0.01),
        'w_rg': nrm(ks[5], (L, RNN_BLOCKS, RNN_BW, RNN_BW), RNN_BW ** -0.5),
        'b_rg': nrm(ks[6], (L, D_RNN), 0.01),
        'w_ig': nrm(ks[7], (L, RNN_BLOCKS, RNN_BW, RNN_BW), RNN_BW ** -0.5),
        'b_ig': nrm(ks[8], (L, D_RNN), 0.01),
        'lru_lambda': lru_lambda,
        'w_rnn_out': nrm(ks[11], (L, D_RNN, D_MODEL), D_RNN ** -0.5),
        'w_att_out': nrm(ks[12], (L, ATT_W, D_MODEL), ATT_W ** -0.5),
        'w_out': nrm(ks[13], (L, D_MODEL, D_MODEL), BETA * D_MODEL ** -0.5),
        'ln1_g': 1.0 + nrm(ks[14], (L, D_MODEL), 0.02),
        'ln1_b': nrm(ks[15], (L, D_MODEL), 0.02),
        'w_router': nrm(ks[16], (L, D_MODEL, N_EXPERTS), D_MODEL ** -0.5),
        'b_router': nrm(ks[17], (L, N_EXPERTS), 0.01),
        'w_gate': nrm(ks[18], (L, N_EXPERTS, D_MODEL, D_FF), BETA * D_MODEL ** -0.5),
        'b_gate': nrm(ks[19], (L, N_EXPERTS, D_FF), 0.01),
        'w_up': nrm(ks[20], (L, N_EXPERTS, D_MODEL, D_FF), BETA * D_MODEL ** -0.5),
        'b_up': nrm(ks[21], (L, N_EXPERTS, D_FF), 0.01),
        'w_down': nrm(ks[22], (L, N_EXPERTS, D_FF, D_MODEL), BETA * D_FF ** -0.5),
        'b_down': nrm(ks[23], (L, N_EXPERTS, D_MODEL), 0.01),
        'ln2_g': 1.0 + nrm(ks[24], (L, D_MODEL), 0.02),
        'ln2_b': nrm(ks[25], (L, D_MODEL), 0.02),
        'w_ple': nrm(ks[26], (L, PLE_DIM, D_MODEL), BETA * PLE_DIM ** -0.5),
        'w_ple_gate': nrm(ks[27], (L, D_MODEL, D_MODEL), D_MODEL ** -0.5),
        'b_ple_gate': nrm(ks[28], (L, D_MODEL), 0.01),
        'ln3_g': 1.0 + nrm(ks[29], (L, D_MODEL), 0.02),
        'ln3_b': nrm(ks[30], (L, D_MODEL), 0.02),
    }


def reference(x, p, w_in, conv_w, conv_b, w_rg, b_rg, w_ig, b_ig, lru_lambda, w_rnn_out,
              w_att_out, w_out, ln1_g, ln1_b, w_router, b_router, w_gate, b_gate, w_up, b_up,
              w_down, b_down, ln2_g, ln2_b, w_ple, w_ple_gate, b_ple_gate, ln3_g, ln3_b):
    for i in range(DEPTH):
        h = _mixer(x, w_in[i], conv_w[i], conv_b[i], w_rg[i], b_rg[i], w_ig[i], b_ig[i],
                   lru_lambda[i], w_rnn_out[i], w_att_out[i], w_out[i])
        x = _layer_norm(ALPHA * x + h, ln1_g[i], ln1_b[i])
        h = _moe(x, w_router[i], b_router[i], w_gate[i], b_gate[i], w_up[i], b_up[i],
                 w_down[i], b_down[i])
        x = _layer_norm(ALPHA * x + h, ln2_g[i], ln2_b[i])
        ple = (p[i] @ w_ple[i]) * jax.nn.sigmoid(x @ w_ple_gate[i] + b_ple_gate[i])
        x = _layer_norm(ALPHA * x + ple, ln3_g[i], ln3_b[i])
    return x
```

```cpp
#include <hip/hip_runtime.h>
#include <stdint.h>
#include <stdio.h>

typedef unsigned short bf16_t;
typedef float f32x4 __attribute__((ext_vector_type(4)));
typedef unsigned u32x4 __attribute__((ext_vector_type(4)));
typedef unsigned u32x2 __attribute__((ext_vector_type(2)));

constexpr int NB = 4, SEQ = 4096, T = NB * SEQ, D = 1024, NIN = 8704, NE = 32, TOPK = 4, PLED = 256;
constexpr int NSLOT = T * TOPK + NE * 256;
constexpr float ALPHA = 1.41421356237309515f;
constexpr float LN_EPS = 1e-5f;
constexpr int KP = 1280;
constexpr int KC = 1536;

constexpr size_t MiB = 1u << 20;
constexpr size_t WS_CTL = 0, CTL_BYTES = 1 * MiB;
constexpr size_t WS_SEG = 1 * MiB, WS_ROUTE = 3 * MiB, WS_LSE = 4 * MiB;
constexpr size_t WS_WIN = 6 * MiB, WS_WG = 23 * MiB, WS_WCAT = 24 * MiB, WS_WOUT = 27 * MiB, WS_WPLE = 29 * MiB, WS_WGU = 32 * MiB, WS_WD = 160 * MiB;
constexpr size_t WS_XA = 224 * MiB, WS_V = 288 * MiB, WS_XBF = 352 * MiB, WS_ACAT2 = 384 * MiB, WS_R = 424 * MiB, WS_END = 856 * MiB;
constexpr size_t R_XR = 0, R_GYR = 32 * MiB, R_QKV = 64 * MiB, R_GR = 208 * MiB, R_GB = 240 * MiB, R_OG = 272 * MiB, R_ACAT = 320 * MiB, R_MERGED = 368 * MiB, R_XC = 400 * MiB;
constexpr size_t R_AA = 64 * MiB, R_BX = 128 * MiB;
constexpr size_t R_XG = 0, R_H = 144 * MiB, R_YB = 288 * MiB;
constexpr int CW_CNT = 1024, CW_CUR = 1024 + 64;

struct Params { const float* in[30]; float* out; unsigned char* ws; };

__device__ __forceinline__ float bf2f(bf16_t h) { return __uint_as_float((unsigned)h << 16); }
__device__ __forceinline__ unsigned f2bf(float f) { unsigned u = __float_as_uint(f); return (u + 0x7fffu + ((u >> 16) & 1u)) >> 16; }
__device__ __forceinline__ unsigned pk2(float lo, float hi) { return f2bf(lo) | (f2bf(hi) << 16); }
__device__ __forceinline__ float sigmoidf_(float x) { return 1.f / (1.f + __expf(-x)); }
__device__ __forceinline__ float gelu_tanh(float x) { const float u = 0.7978845608028654f * (x + 0.044715f * x * x * x); const float e = __expf(2.f * u); const float th = 1.f - 2.f / (e + 1.f); return 0.5f * x * (1.f + th); }
__device__ __forceinline__ float wave_sum(float v) {
#pragma unroll
    for (int o = 1; o < 64; o <<= 1) v += __shfl_xor(v, o);
    return v;
}

struct Ctx {
    int layer;
    const float* xin; float *x1, *x2, *x3, *V;
    const float *p, *w_in, *conv_w, *conv_b, *w_rg, *b_rg, *w_ig, *b_ig, *lam, *w_rnn_out, *w_att_out, *w_out, *ln1g, *ln1b, *w_router, *b_router,
        *w_gate, *b_gate, *w_up, *b_up, *w_down, *b_down, *ln2g, *ln2b, *w_ple, *w_pg, *b_pg, *ln3g, *ln3b;
    bf16_t *WIN, *WG, *WCAT, *WOUT, *WPLE, *WGU, *WD;
    bf16_t *XBF, *ACAT2, *XR, *GYR, *QKV, *GR, *GB, *OG, *ACAT, *MERGED, *XC, *XG, *H, *YB;
    float *AA, *BX, *SEGS, *LSE;
    int *TOPE, *SLOT; float* TOPG;
    unsigned *CNT, *CUR;
};
__device__ __forceinline__ Ctx make_ctx(const Params& P, int l) {
    Ctx c; c.layer = l; unsigned char* ws = P.ws;
    float* XA = (float*)(ws + WS_XA);
    if (l == 0) { c.xin = P.in[0]; c.x1 = XA; c.x2 = P.out; c.x3 = XA; } else { c.xin = XA; c.x1 = P.out; c.x2 = XA; c.x3 = P.out; }
    c.V = (float*)(ws + WS_V);
    c.p = P.in[1] + (size_t)l * T * PLED; c.w_in = P.in[2] + (size_t)l * D * NIN; c.conv_w = P.in[3] + l * 4 * D; c.conv_b = P.in[4] + l * D;
    c.w_rg = P.in[5] + (size_t)l * 4 * 256 * 256; c.b_rg = P.in[6] + l * D; c.w_ig = P.in[7] + (size_t)l * 4 * 256 * 256; c.b_ig = P.in[8] + l * D; c.lam = P.in[9] + l * D;
    c.w_rnn_out = P.in[10] + (size_t)l * D * D; c.w_att_out = P.in[11] + (size_t)l * 512 * D; c.w_out = P.in[12] + (size_t)l * D * D; c.ln1g = P.in[13] + l * D; c.ln1b = P.in[14] + l * D;
    c.w_router = P.in[15] + (size_t)l * D * NE; c.b_router = P.in[16] + l * NE;
    c.w_gate = P.in[17] + (size_t)l * NE * D * D; c.b_gate = P.in[18] + (size_t)l * NE * D; c.w_up = P.in[19] + (size_t)l * NE * D * D; c.b_up = P.in[20] + (size_t)l * NE * D;
    c.w_down = P.in[21] + (size_t)l * NE * D * D; c.b_down = P.in[22] + (size_t)l * NE * D; c.ln2g = P.in[23] + l * D; c.ln2b = P.in[24] + l * D;
    c.w_ple = P.in[25] + (size_t)l * PLED * D; c.w_pg = P.in[26] + (size_t)l * D * D; c.b_pg = P.in[27] + l * D; c.ln3g = P.in[28] + l * D; c.ln3b = P.in[29] + l * D;
    c.WIN = (bf16_t*)(ws + WS_WIN); c.WG = (bf16_t*)(ws + WS_WG); c.WCAT = (bf16_t*)(ws + WS_WCAT); c.WOUT = (bf16_t*)(ws + WS_WOUT); c.WPLE = (bf16_t*)(ws + WS_WPLE);
    c.WGU = (bf16_t*)(ws + WS_WGU); c.WD = (bf16_t*)(ws + WS_WD);
    c.XBF = (bf16_t*)(ws + WS_XBF); c.ACAT2 = (bf16_t*)(ws + WS_ACAT2);
    unsigned char* R = ws + WS_R;
    c.XR = (bf16_t*)(R + R_XR); c.GYR = (bf16_t*)(R + R_GYR); c.QKV = (bf16_t*)(R + R_QKV); c.GR = (bf16_t*)(R + R_GR); c.GB = (bf16_t*)(R + R_GB);
    c.OG = (bf16_t*)(R + R_OG); c.ACAT = (bf16_t*)(R + R_ACAT); c.MERGED = (bf16_t*)(R + R_MERGED); c.XC = (bf16_t*)(R + R_XC);
    c.XG = (bf16_t*)(R + R_XG); c.H = (bf16_t*)(R + R_H); c.YB = (bf16_t*)(R + R_YB);
    c.AA = (float*)(R + R_AA); c.BX = (float*)(R + R_BX); c.SEGS = (float*)(ws + WS_SEG); c.LSE = (float*)(ws + WS_LSE);
    c.TOPE = (int*)(ws + WS_ROUTE); c.TOPG = (float*)(ws + WS_ROUTE + 256 * 1024); c.SLOT = (int*)(ws + WS_ROUTE + 512 * 1024);
    c.CNT = (unsigned*)(ws + WS_CTL) + CW_CNT + 128 * l; c.CUR = (unsigned*)(ws + WS_CTL) + CW_CUR + 128 * l;
    return c;
}
__device__ __forceinline__ int dil_of(int g) { return 1 << (2 * g); }
__device__ __forceinline__ int split_row(int g, int tok) { const int d = dil_of(g), b = tok / SEQ, s = tok % SEQ; return (b * d + (s % d)) * (SEQ / d) + s / d; }
__device__ __forceinline__ int token_of_split(int g, int sr) { const int d = dil_of(g), L = SEQ / d, bd = sr / L, l = sr % L; return (bd / d) * SEQ + l * d + (bd % d); }

struct CvtJob { const float* W; int lds; int K, N; bf16_t* dst; int ldd; int mode, ty; };
__device__ __forceinline__ int cvt_items(const CvtJob& j) { return (j.K / 64) * (j.N / 32); }
__device__ __forceinline__ CvtJob cvt_job(const Ctx& c, int j) {
    CvtJob r;
    if (j == 0) { r = {c.w_in, NIN, D, 6656, c.WIN, D, 0, 0}; }
    else if (j == 1) { r = {c.w_in + 6656, NIN, D, 1024, c.WIN + (size_t)6656 * D, D, 1, 0}; }
    else if (j == 2) { r = {c.w_in + 7680, NIN, D, 1024, c.WIN + (size_t)6656 * D, D, 1, 1}; }
    else if (j < 11) { const int q = j - 3, nb = q >> 1, gt = q & 1; r = {(gt ? c.w_ig : c.w_rg) + (size_t)nb * 65536, 256, 256, 256, c.WG + (size_t)nb * 512 * 256, 256, 1, gt}; }
    else if (j == 11) { r = {c.w_rnn_out, D, D, D, c.WCAT, KC, 0, 0}; }
    else if (j == 12) { r = {c.w_att_out, D, 512, D, c.WCAT + 1024, KC, 0, 0}; }
    else if (j == 13) { r = {c.w_out, D, D, D, c.WOUT, D, 0, 0}; }
    else if (j == 14) { r = {c.w_ple, D, PLED, D, c.WPLE, KP, 0, 0}; }
    else if (j == 15) { r = {c.w_pg, D, D, D, c.WPLE + 256, KP, 0, 0}; }
    else { const int q = j - 16, e = q / 3, w = q % 3;
        if (w == 0) r = {c.w_gate + (size_t)e * D * D, D, D, D, c.WGU + (size_t)e * 2048 * D, D, 1, 0};
        else if (w == 1) r = {c.w_up + (size_t)e * D * D, D, D, D, c.WGU + (size_t)e * 2048 * D, D, 1, 1};
        else r = {c.w_down + (size_t)e * D * D, D, D, D, c.WD + (size_t)e * D * D, D, 0, 0}; }
    return r;
}
constexpr int CVT_NJOBS = 16 + 3 * NE;
__device__ __forceinline__ void cvt_item(const CvtJob& J, int item, float* scr, int lane) {
    const int nblk = J.N / 32, kb = item / nblk, nb = item % nblk, k0 = 64 * kb, n0 = 32 * nb;
#pragma unroll 8
    for (int i = 0; i < 32; ++i) { const int kk = 2 * i + (lane >> 5); scr[kk * 33 + (lane & 31)] = J.W[(size_t)(k0 + kk) * J.lds + n0 + (lane & 31)]; }
    __builtin_amdgcn_s_waitcnt(0xc07f); asm volatile("" ::: "memory");
    const int cch = lane & 7;
    const int r0 = J.mode ? ((n0 >> 7) * 256 + J.ty * 128 + (n0 & 127)) : n0;
#pragma unroll
    for (int j = 0; j < 4; ++j) { const int n = (lane >> 3) + 8 * j; const float* s = scr + (8 * cch) * 33 + n;
        u32x4 o; o.x = pk2(s[0 * 33], s[1 * 33]); o.y = pk2(s[2 * 33], s[3 * 33]); o.z = pk2(s[4 * 33], s[5 * 33]); o.w = pk2(s[6 * 33], s[7 * 33]);
        *(u32x4*)(J.dst + (size_t)(r0 + n) * J.ldd + k0 + 8 * cch) = o; }
    __builtin_amdgcn_s_waitcnt(0xc07f); asm volatile("" ::: "memory");
}
__device__ void phase_convert(const Ctx& c, float* scr_all, int vb, int nb) {
    const int tid = threadIdx.x, lane = tid & 63, wave = tid >> 6, nwv = blockDim.x >> 6;
    float* scr = scr_all + wave * (64 * 33);
    const int gw = vb * nwv + wave, NGW = nb * nwv;
    int base = 0;
    for (int j = 0; j < CVT_NJOBS; ++j) {
        const CvtJob J = cvt_job(c, j); const int ni = cvt_items(J);
        int first = gw - (base % NGW); if (first < 0) first += NGW;
        for (int it = first; it < ni; it += NGW) cvt_item(J, it, scr, lane);
        base += ni;
    }
    if (c.layer == 0) {
        for (size_t i = (size_t)(vb * blockDim.x + tid); i < (size_t)T * D / 4; i += (size_t)nb * blockDim.x) {
            const f32x4 v = *(const f32x4*)(c.xin + 4 * i); u32x2 o; o.x = pk2(v.x, v.y); o.y = pk2(v.z, v.w); *(u32x2*)(c.XBF + 4 * i) = o; }
    }
    for (size_t i = (size_t)(vb * blockDim.x + tid); i < (size_t)T * PLED / 4; i += (size_t)nb * blockDim.x) {
        const f32x4 v = *(const f32x4*)(c.p + 4 * i); u32x2 o; o.x = pk2(v.x, v.y); o.y = pk2(v.z, v.w);
        const size_t row = (4 * i) / PLED, col = (4 * i) % PLED; *(u32x2*)(c.ACAT2 + row * KP + col) = o; }
}

struct Unit { int pm, pn, e; };

struct JobInproj {
    static constexpr int K = 1024, KMID = 0, MAXU = 64 * 34;
    Ctx c; __device__ JobInproj(const Ctx& c_) : c(c_) {}
    __device__ bool unit(int idx, Unit& u, const bf16_t*& A, int& lda, const bf16_t*& Bt, int& ldb) const {
        if (idx >= MAXU) return false; u.pm = idx % 64; u.pn = idx / 64; u.e = 0;
        A = c.XBF + (size_t)u.pm * 256 * D; lda = D; Bt = c.WIN + (size_t)u.pn * 256 * D; ldb = D; return true; }
    __device__ void mid(const Unit&, int, int, f32x4&, f32x4&) const {}
    __device__ void epi(const Unit& u, int row, int col, f32x4 v0, f32x4 v1) const {
        if (col < 1024) { st4(c.XR + (size_t)row * D + col, v0); st4(c.XR + (size_t)row * D + col + 128, v1); }
        else if (col < 2048) { const int cc = col - 1024; f32x4 a, b;
            for (int j = 0; j < 4; ++j) { a[j] = gelu_tanh(v0[j]); b[j] = gelu_tanh(v1[j]); }
            st4(c.GYR + (size_t)row * D + cc, a); st4(c.GYR + (size_t)row * D + cc + 128, b); }
        else if (col < 6656) { const int q = col - 2048, which = q / 1536, g = (q % 1536) / 512, cc = q % 512;
            const float sc = which == 0 ? 0.125f : 1.f; bf16_t* dst = c.QKV + (size_t)(g * 3 + which) * T * 512 + (size_t)split_row(g, row) * 512 + cc;
            st4(dst, v0 * sc); st4(dst + 128, v1 * sc); }
        else { const int cc = (col - 6656) / 256 * 128 + (col - 6656) % 256;
            f32x4 r, s; for (int j = 0; j < 4; ++j) { const float sa = sigmoidf_(v0[j]), sb = sigmoidf_(v1[j]); r[j] = sa / sb; s[j] = sb; }
            st4(c.GR + (size_t)row * D + cc, r); st4(c.GB + (size_t)row * D + cc, s); }
    }
    static __device__ __forceinline__ void st4(bf16_t* p, f32x4 v) { u32x2 o; o.x = pk2(v[0], v[1]); o.y = pk2(v[2], v[3]); *(u32x2*)p = o; }
};
struct JobGate {
    static constexpr int K = 256, KMID = 0, MAXU = 64 * 8;
    Ctx c; __device__ JobGate(const Ctx& c_) : c(c_) {}
    __device__ bool unit(int idx, Unit& u, const bf16_t*& A, int& lda, const bf16_t*& Bt, int& ldb) const {
        if (idx >= MAXU) return false; u.pm = idx % 64; u.pn = idx / 64; u.e = 0;
        A = c.XC + (size_t)u.pm * 256 * D + (u.pn >> 1) * 256; lda = D; Bt = c.WG + (size_t)u.pn * 256 * 256; ldb = 256; return true; }
    __device__ void mid(const Unit&, int, int, f32x4&, f32x4&) const {}
    __device__ void epi(const Unit& u, int row, int col, f32x4 v0, f32x4 v1) const {
        const int ch = (col >> 8) * 128 + (col & 255);
        f32x4 a, bx;
        for (int j = 0; j < 4; ++j) { const int cc = ch + j;
            const float r = sigmoidf_(v0[j] + c.b_rg[cc]), ig = sigmoidf_(v1[j] + c.b_ig[cc]);
            const float sp = log1pf(__expf(-c.lam[cc])); const float la = -8.f * r * sp; const float av = __expf(la);
            const float xc = bf2f(c.XC[(size_t)row * D + cc]);
            a[j] = av; bx[j] = sqrtf(-expm1f(2.f * la)) * (ig * xc); }
        *(f32x4*)(c.AA + (size_t)row * D + ch) = a; *(f32x4*)(c.BX + (size_t)row * D + ch) = bx;
    }
};
struct JobY {
    static constexpr int K = KC, KMID = 1024, MAXU = 64 * 4;
    Ctx c; __device__ JobY(const Ctx& c_) : c(c_) {}
    __device__ bool unit(int idx, Unit& u, const bf16_t*& A, int& lda, const bf16_t*& Bt, int& ldb) const {
        if (idx >= MAXU) return false; u.pm = idx % 64; u.pn = idx / 64; u.e = 0;
        A = c.ACAT + (size_t)u.pm * 256 * KC; lda = KC; Bt = c.WCAT + (size_t)u.pn * 256 * KC; ldb = KC; return true; }
    __device__ void mid(const Unit&, int row, int col, f32x4& v0, f32x4& v1) const {
        for (int j = 0; j < 4; ++j) { v0[j] *= bf2f(c.GR[(size_t)row * D + col + j]); v1[j] *= bf2f(c.GR[(size_t)row * D + col + 128 + j]); } }
    __device__ void epi(const Unit&, int row, int col, f32x4 v0, f32x4 v1) const {
        for (int j = 0; j < 4; ++j) { v0[j] *= bf2f(c.GB[(size_t)row * D + col + j]); v1[j] *= bf2f(c.GB[(size_t)row * D + col + 128 + j]); }
        JobInproj::st4(c.MERGED + (size_t)row * D + col, v0); JobInproj::st4(c.MERGED + (size_t)row * D + col + 128, v1); }
};
struct JobOut {
    static constexpr int K = 1024, KMID = 0, MAXU = 64 * 4;
    Ctx c; __device__ JobOut(const Ctx& c_) : c(c_) {}
    __device__ bool unit(int idx, Unit& u, const bf16_t*& A, int& lda, const bf16_t*& Bt, int& ldb) const {
        if (idx >= MAXU) return false; u.pm = idx % 64; u.pn = idx / 64; u.e = 0;
        A = c.MERGED + (size_t)u.pm * 256 * D; lda = D; Bt = c.WOUT + (size_t)u.pn * 256 * D; ldb = D; return true; }
    __device__ void mid(const Unit&, int, int, f32x4&, f32x4&) const {}
    __device__ void epi(const Unit&, int row, int col, f32x4 v0, f32x4 v1) const {
        const f32x4 x0 = *(const f32x4*)(c.xin + (size_t)row * D + col), x1 = *(const f32x4*)(c.xin + (size_t)row * D + col + 128);
        *(f32x4*)(c.V + (size_t)row * D + col) = x0 * ALPHA + v0; *(f32x4*)(c.V + (size_t)row * D + col + 128) = x1 * ALPHA + v1; }
};
__device__ __forceinline__ bool moe_tile(const unsigned* CNT, int mt, int& e) {
    int acc = 0;
    for (int i = 0; i < NE; ++i) { const int nt = (int)((CNT[i] + 255u) >> 8); if (mt < acc + nt) { e = i; return true; } acc += nt; }
    return false;
}
struct JobMoeGU {
    static constexpr int K = 1024, KMID = 0, MAXU = 288 * 8;
    Ctx c; __device__ JobMoeGU(const Ctx& c_) : c(c_) {}
    __device__ bool unit(int idx, Unit& u, const bf16_t*& A, int& lda, const bf16_t*& Bt, int& ldb) const {
        u.pm = idx / 8; u.pn = idx % 8; if (u.pm >= 288 || !moe_tile(c.CNT, u.pm, u.e)) return false;
        A = c.XG + (size_t)u.pm * 256 * D; lda = D; Bt = c.WGU + (size_t)u.e * 2048 * D + (size_t)u.pn * 256 * D; ldb = D; return true; }
    __device__ void mid(const Unit&, int, int, f32x4&, f32x4&) const {}
    __device__ void epi(const Unit& u, int row, int col, f32x4 v0, f32x4 v1) const {
        const int ch = (col >> 8) * 128 + (col & 255); f32x4 h;
        for (int j = 0; j < 4; ++j) { float g = v0[j] + c.b_gate[u.e * D + ch + j], up = v1[j] + c.b_up[u.e * D + ch + j];
            g = fminf(g, 7.f); up = fminf(fmaxf(up, -7.f), 7.f); h[j] = (up + 1.f) * (g * sigmoidf_(1.702f * g)); }
        JobInproj::st4(c.H + (size_t)row * D + ch, h); }
};
struct JobMoeD {
    static constexpr int K = 1024, KMID = 0, MAXU = 288 * 4;
    Ctx c; __device__ JobMoeD(const Ctx& c_) : c(c_) {}
    __device__ bool unit(int idx, Unit& u, const bf16_t*& A, int& lda, const bf16_t*& Bt, int& ldb) const {
        u.pm = idx / 4; u.pn = idx % 4; if (u.pm >= 288 || !moe_tile(c.CNT, u.pm, u.e)) return false;
        A = c.H + (size_t)u.pm * 256 * D; lda = D; Bt = c.WD + (size_t)u.e * D * D + (size_t)u.pn * 256 * D; ldb = D; return true; }
    __device__ void mid(const Unit&, int, int, f32x4&, f32x4&) const {}
    __device__ void epi(const Unit& u, int row, int col, f32x4 v0, f32x4 v1) const {
        const f32x4 b0 = *(const f32x4*)(c.b_down + u.e * D + col), b1 = *(const f32x4*)(c.b_down + u.e * D + col + 128);
        JobInproj::st4(c.YB + (size_t)row * D + col, v0 + b0); JobInproj::st4(c.YB + (size_t)row * D + col + 128, v1 + b1); }
};
struct JobPle {
    static constexpr int K = KP, KMID = 256, MAXU = 64 * 4;
    Ctx c; __device__ JobPle(const Ctx& c_) : c(c_) {}
    __device__ bool unit(int idx, Unit& u, const bf16_t*& A, int& lda, const bf16_t*& Bt, int& ldb) const {
        if (idx >= MAXU) return false; u.pm = idx % 64; u.pn = idx / 64; u.e = 0;
        A = c.ACAT2 + (size_t)u.pm * 256 * KP; lda = KP; Bt = c.WPLE + (size_t)u.pn * 256 * KP; ldb = KP; return true; }
    __device__ void mid(const Unit&, int row, int col, f32x4& v0, f32x4& v1) const {
        *(f32x4*)(c.V + (size_t)row * D + col) = v0; *(f32x4*)(c.V + (size_t)row * D + col + 128) = v1; v0 = (f32x4){0.f, 0.f, 0.f, 0.f}; v1 = v0; }
    __device__ void epi(const Unit&, int row, int col, f32x4 v0, f32x4 v1) const {
        float* vp = c.V + (size_t)row * D + col; const float* xp = c.x2 + (size_t)row * D + col;
        f32x4 l0 = *(f32x4*)vp, l1 = *(f32x4*)(vp + 128); const f32x4 x0 = *(const f32x4*)xp, x1 = *(const f32x4*)(xp + 128);
        for (int j = 0; j < 4; ++j) { l0[j] = ALPHA * x0[j] + l0[j] * sigmoidf_(v0[j] + c.b_pg[col + j]); l1[j] = ALPHA * x1[j] + l1[j] * sigmoidf_(v1[j] + c.b_pg[col + 128 + j]); }
        *(f32x4*)vp = l0; *(f32x4*)(vp + 128) = l1; }
};

template <class Job> __global__ void __launch_bounds__(256) sgemm_kernel(Params P, int layer) {
    __shared__ float As[16][129]; __shared__ float Bs[16][65];
    const Ctx c = make_ctx(P, layer); const Job J(c);
    const int idx = blockIdx.x >> 3, sub = blockIdx.x & 7, rh = sub >> 2, cs = sub & 3;
    Unit u; const bf16_t *A, *Bt; int lda, ldb;
    if (!J.unit(idx, u, A, lda, Bt, ldb)) return;
    const int tid = threadIdx.x, cg = tid & 7, rg = tid >> 3;
    A += (size_t)rh * 128 * lda;
    f32x4 acc0[4], acc1[4];
    for (int i = 0; i < 4; ++i) { acc0[i] = (f32x4){0.f, 0.f, 0.f, 0.f}; acc1[i] = acc0[i]; }
    const int row0 = u.pm * 256 + rh * 128 + rg * 4, col0 = u.pn * 256 + cs * 32 + cg * 4;
    for (int k0 = 0; k0 < Job::K; k0 += 16) {
        if (Job::KMID > 0 && k0 == Job::KMID) { for (int i = 0; i < 4; ++i) J.mid(u, row0 + i, col0, acc0[i], acc1[i]); }
        { const int r = tid >> 1, kq = (tid & 1) * 8; const u32x4 v = *(const u32x4*)(A + (size_t)r * lda + k0 + kq);
          for (int j = 0; j < 4; ++j) { As[kq + 2 * j][r] = __uint_as_float(v[j] << 16); As[kq + 2 * j + 1][r] = __uint_as_float(v[j] & 0xffff0000u); } }
        { const int jn = tid >> 2, kq = (tid & 3) * 4; const int n = (jn < 32) ? cs * 32 + jn : 128 + cs * 32 + (jn - 32);
          const u32x2 v = *(const u32x2*)(Bt + (size_t)n * ldb + k0 + kq);
          for (int j = 0; j < 2; ++j) { Bs[kq + 2 * j][jn] = __uint_as_float(v[j] << 16); Bs[kq + 2 * j + 1][jn] = __uint_as_float(v[j] & 0xffff0000u); } }
        __syncthreads();
#pragma unroll
        for (int k = 0; k < 16; ++k) {
            float a[4], b0[4], b1[4];
            for (int i = 0; i < 4; ++i) a[i] = As[k][rg * 4 + i];
            for (int j = 0; j < 4; ++j) { b0[j] = Bs[k][cg * 4 + j]; b1[j] = Bs[k][32 + cg * 4 + j]; }
            for (int i = 0; i < 4; ++i) for (int j = 0; j < 4; ++j) { acc0[i][j] += a[i] * b0[j]; acc1[i][j] += a[i] * b1[j]; }
        }
        __syncthreads();
    }
    for (int i = 0; i < 4; ++i) J.epi(u, row0 + i, col0, acc0[i], acc1[i]);
}

__device__ void phase_conv(const Ctx& c, int vb, int nb) {
    for (size_t i = (size_t)vb * blockDim.x + threadIdx.x; i < (size_t)T * D / 4; i += (size_t)nb * blockDim.x) {
        const int t = (int)((4 * i) / D), ch = (int)((4 * i) % D), s = t % SEQ;
        f32x4 acc = *(const f32x4*)(c.conv_b + ch);
#pragma unroll
        for (int w = 0; w < 4; ++w) { const int ss = s - 3 + w; if (ss < 0) continue;
            const u32x2 v = *(const u32x2*)(c.XR + (size_t)(t - 3 + w) * D + ch); const f32x4 cw = *(const f32x4*)(c.conv_w + w * D + ch);
            acc[0] += cw[0] * __uint_as_float(v.x << 16); acc[1] += cw[1] * __uint_as_float(v.x & 0xffff0000u);
            acc[2] += cw[2] * __uint_as_float(v.y << 16); acc[3] += cw[3] * __uint_as_float(v.y & 0xffff0000u); }
        u32x2 o; o.x = pk2(acc[0], acc[1]); o.y = pk2(acc[2], acc[3]); *(u32x2*)(c.XC + (size_t)t * D + ch) = o;
    }
}
__device__ void phase_attn_simple(const Ctx& c, int vb, int nb) {
    for (int i = vb * blockDim.x + threadIdx.x; i < 3 * T * 8; i += nb * blockDim.x) {
        const int h = i & 7, sr = (i >> 3) % T, g = i / (8 * T);
        const int d = dil_of(g), L = SEQ / d, l = sr % L;
        const bf16_t* Q = c.QKV + (size_t)(g * 3 + 0) * T * 512; const bf16_t* Kp = c.QKV + (size_t)(g * 3 + 1) * T * 512; const bf16_t* Vp = c.QKV + (size_t)(g * 3 + 2) * T * 512;
        float q[64], o[64];
        for (int j = 0; j < 64; ++j) { q[j] = bf2f(Q[(size_t)sr * 512 + h * 64 + j]); o[j] = 0.f; }
        float m = -INFINITY, sum = 0.f;
        const int lo = l - 128 < 0 ? 0 : l - 128;
        for (int lk = lo; lk <= l; ++lk) { const size_t kr = (size_t)(sr - l + lk) * 512 + h * 64;
            float s = 0.f; for (int j = 0; j < 64; ++j) s += q[j] * bf2f(Kp[kr + j]);
            const float mn = fmaxf(m, s), f = __expf(m - mn), pz = __expf(s - mn);
            sum = sum * f + pz; for (int j = 0; j < 64; ++j) o[j] = o[j] * f + pz * bf2f(Vp[kr + j]); m = mn; }
        const int tok = token_of_split(g, sr); const float inv = 1.f / sum;
        bf16_t* op = c.OG + (size_t)g * T * 512 + (size_t)tok * 512 + h * 64;
        for (int j = 0; j < 64; j += 2) *(unsigned*)(op + j) = pk2(o[j] * inv, o[j + 1] * inv);
        c.LSE[((size_t)g * T + tok) * 8 + h] = m + __logf(sum);
    }
}
__device__ void phase_scan1(const Ctx& c, int vb, int nb) {
    for (int u = vb; u < NB * 64 * 2; u += nb) {
        const int half = u & 1, seg = (u >> 1) & 63, b = u >> 7; const int ch = half * 512 + threadIdx.x;
        const size_t base = ((size_t)b * SEQ + seg * 64) * D + ch; float P = 1.f, h = 0.f;
#pragma unroll 8
        for (int s = 0; s < 64; ++s) { const float a = c.AA[base + (size_t)s * D], bx = c.BX[base + (size_t)s * D]; h = a * h + bx; P *= a; c.AA[base + (size_t)s * D] = P; c.BX[base + (size_t)s * D] = h; }
        float* sg = c.SEGS + (((size_t)b * 64 + seg) * D + ch) * 2; sg[0] = P; sg[1] = h;
    }
}
__device__ void phase_attn_mix(const Ctx& c, int vb, int nb) {
    for (size_t i = (size_t)vb * blockDim.x + threadIdx.x; i < (size_t)T * 512 / 4; i += (size_t)nb * blockDim.x) {
        const int t = (int)((4 * i) / 512), col = (int)((4 * i) % 512), h = col >> 6;
        const float l0 = c.LSE[((size_t)0 * T + t) * 8 + h], l1 = c.LSE[((size_t)1 * T + t) * 8 + h], l2 = c.LSE[((size_t)2 * T + t) * 8 + h];
        const float m = fmaxf(l0, fmaxf(l1, l2)); float w0 = __expf(l0 - m), w1 = __expf(l1 - m), w2 = __expf(l2 - m); const float inv = 1.f / (w0 + w1 + w2); w0 *= inv; w1 *= inv; w2 *= inv;
        const u32x2 a = *(const u32x2*)(c.OG + (size_t)0 * T * 512 + (size_t)t * 512 + col), b = *(const u32x2*)(c.OG + (size_t)1 * T * 512 + (size_t)t * 512 + col), d = *(const u32x2*)(c.OG + (size_t)2 * T * 512 + (size_t)t * 512 + col);
        f32x4 o;
        o[0] = w0 * __uint_as_float(a.x << 16) + w1 * __uint_as_float(b.x << 16) + w2 * __uint_as_float(d.x << 16);
        o[1] = w0 * __uint_as_float(a.x & 0xffff0000u) + w1 * __uint_as_float(b.x & 0xffff0000u) + w2 * __uint_as_float(d.x & 0xffff0000u);
        o[2] = w0 * __uint_as_float(a.y << 16) + w1 * __uint_as_float(b.y << 16) + w2 * __uint_as_float(d.y << 16);
        o[3] = w0 * __uint_as_float(a.y & 0xffff0000u) + w1 * __uint_as_float(b.y & 0xffff0000u) + w2 * __uint_as_float(d.y & 0xffff0000u);
        u32x2 r; r.x = pk2(o[0], o[1]); r.y = pk2(o[2], o[3]); *(u32x2*)(c.ACAT + (size_t)t * KC + 1024 + col) = r;
    }
}
__device__ void phase_scan2(const Ctx& c, int vb, int nb) {
    for (int u = vb; u < NB * 64 * 2; u += nb) {
        const int half = u & 1, seg = (u >> 1) & 63, b = u >> 7; const int ch = half * 512 + threadIdx.x;
        float carry = 0.f;
        for (int s = 0; s < seg; ++s) { const float* sg = c.SEGS + (((size_t)b * 64 + s) * D + ch) * 2; carry = sg[0] * carry + sg[1]; }
        const size_t t0 = (size_t)b * SEQ + seg * 64;
#pragma unroll 8
        for (int s = 0; s < 64; ++s) { const size_t o = (t0 + s) * D + ch; const float h = c.BX[o] + c.AA[o] * carry;
            c.ACAT[(t0 + s) * KC + ch] = (bf16_t)f2bf(bf2f(c.GYR[o]) * h); }
    }
}
__device__ __forceinline__ void ln_row(f32x4 (&v)[4], const float* g, const float* b, int lane) {
    float s = 0.f;
#pragma unroll
    for (int j = 0; j < 4; ++j) s += (v[j][0] + v[j][1]) + (v[j][2] + v[j][3]);
    const float mean = wave_sum(s) * (1.f / D); float s2 = 0.f;
#pragma unroll
    for (int j = 0; j < 4; ++j) { v[j] = v[j] - mean; s2 += (v[j][0] * v[j][0] + v[j][1] * v[j][1]) + (v[j][2] * v[j][2] + v[j][3] * v[j][3]); }
    const float rstd = 1.f / sqrtf(wave_sum(s2) * (1.f / D) + LN_EPS);
#pragma unroll
    for (int j = 0; j < 4; ++j) { const f32x4 gg = *(const f32x4*)(g + 4 * lane + 256 * j), bb = *(const f32x4*)(b + 4 * lane + 256 * j); v[j] = v[j] * rstd * gg + bb; }
}
__device__ void phase_ln1_router(const Ctx& c, int vb, int nb) {
    const int lane = threadIdx.x & 63, wave = threadIdx.x >> 6, nwv = blockDim.x >> 6;
    for (int t = vb * nwv + wave; t < T; t += nb * nwv) {
        f32x4 v[4];
#pragma unroll
        for (int j = 0; j < 4; ++j) v[j] = *(const f32x4*)(c.V + (size_t)t * D + 4 * lane + 256 * j);
        ln_row(v, c.ln1g, c.ln1b, lane);
#pragma unroll
        for (int j = 0; j < 4; ++j) *(f32x4*)(c.x1 + (size_t)t * D + 4 * lane + 256 * j) = v[j];
        float lg[32];
#pragma unroll
        for (int e = 0; e < 32; ++e) lg[e] = 0.f;
#pragma unroll
        for (int j = 0; j < 4; ++j)
#pragma unroll
            for (int q = 0; q < 4; ++q) { const int k = 4 * lane + 256 * j + q; const float xv = v[j][q]; const f32x4* wr = (const f32x4*)(c.w_router + (size_t)k * NE);
#pragma unroll
                for (int e4 = 0; e4 < 8; ++e4) { const f32x4 w = wr[e4]; lg[4 * e4] += xv * w[0]; lg[4 * e4 + 1] += xv * w[1]; lg[4 * e4 + 2] += xv * w[2]; lg[4 * e4 + 3] += xv * w[3]; } }
#pragma unroll
        for (int e = 0; e < 32; ++e) lg[e] = wave_sum(lg[e]) + c.b_router[e];
        int te[4]; float tv[4]; unsigned used = 0u;
#pragma unroll
        for (int k = 0; k < 4; ++k) { float best = -INFINITY; int bi = 0;
#pragma unroll
            for (int e = 0; e < 32; ++e) { const bool ok = !((used >> e) & 1u) && lg[e] > best; best = ok ? lg[e] : best; bi = ok ? e : bi; }
            te[k] = bi; tv[k] = best; used |= 1u << bi; }
        const float e1 = __expf(tv[1] - tv[0]), e2 = __expf(tv[2] - tv[0]), e3 = __expf(tv[3] - tv[0]); const float inv = 1.f / (1.f + e1 + e2 + e3);
        if (lane < 4) { const float gk = (lane == 0 ? 1.f : lane == 1 ? e1 : lane == 2 ? e2 : e3) * inv; const int ek = lane == 0 ? te[0] : lane == 1 ? te[1] : lane == 2 ? te[2] : te[3];
            c.TOPE[t * 4 + lane] = ek; c.TOPG[t * 4 + lane] = gk; atomicAdd(&c.CNT[ek], 1u); }
    }
}
__device__ void phase_scatter(const Ctx& c, int vb, int nb) {
    const int lane = threadIdx.x & 63, wave = threadIdx.x >> 6, nwv = blockDim.x >> 6;
    for (int t = vb * nwv + wave; t < T; t += nb * nwv) {
        int slot = 0;
        if (lane < 4) { const int e = c.TOPE[t * 4 + lane]; int base = 0; for (int i = 0; i < e; ++i) base += (int)((c.CNT[i] + 255u) & ~255u);
            slot = base + (int)atomicAdd(&c.CUR[e], 1u); c.SLOT[t * 4 + lane] = slot; }
        u32x2 o[4];
#pragma unroll
        for (int j = 0; j < 4; ++j) { const f32x4 v = *(const f32x4*)(c.x1 + (size_t)t * D + 4 * lane + 256 * j); o[j].x = pk2(v[0], v[1]); o[j].y = pk2(v[2], v[3]); }
#pragma unroll
        for (int k = 0; k < 4; ++k) { const int sl = __shfl(slot, k);
#pragma unroll
            for (int j = 0; j < 4; ++j) *(u32x2*)(c.XG + (size_t)sl * D + 4 * lane + 256 * j) = o[j]; }
    }
}
__device__ void phase_combine_ln2(const Ctx& c, int vb, int nb) {
    const int lane = threadIdx.x & 63, wave = threadIdx.x >> 6, nwv = blockDim.x >> 6;
    for (int t = vb * nwv + wave; t < T; t += nb * nwv) {
        f32x4 v[4];
#pragma unroll
        for (int j = 0; j < 4; ++j) v[j] = *(const f32x4*)(c.x1 + (size_t)t * D + 4 * lane + 256 * j) * ALPHA;
#pragma unroll
        for (int k = 0; k < 4; ++k) { const int sl = c.SLOT[t * 4 + k]; const float gk = c.TOPG[t * 4 + k];
#pragma unroll
            for (int j = 0; j < 4; ++j) { const u32x2 y = *(const u32x2*)(c.YB + (size_t)sl * D + 4 * lane + 256 * j);
                v[j][0] += gk * __uint_as_float(y.x << 16); v[j][1] += gk * __uint_as_float(y.x & 0xffff0000u); v[j][2] += gk * __uint_as_float(y.y << 16); v[j][3] += gk * __uint_as_float(y.y & 0xffff0000u); } }
        ln_row(v, c.ln2g, c.ln2b, lane);
#pragma unroll
        for (int j = 0; j < 4; ++j) { *(f32x4*)(c.x2 + (size_t)t * D + 4 * lane + 256 * j) = v[j]; u32x2 o; o.x = pk2(v[j][0], v[j][1]); o.y = pk2(v[j][2], v[j][3]);
            *(u32x2*)(c.ACAT2 + (size_t)t * KP + 256 + 4 * lane + 256 * j) = o; }
    }
}
__device__ void phase_ln3(const Ctx& c, int vb, int nb) {
    const int lane = threadIdx.x & 63, wave = threadIdx.x >> 6, nwv = blockDim.x >> 6;
    for (int t = vb * nwv + wave; t < T; t += nb * nwv) {
        f32x4 v[4];
#pragma unroll
        for (int j = 0; j < 4; ++j) v[j] = *(const f32x4*)(c.V + (size_t)t * D + 4 * lane + 256 * j);
        ln_row(v, c.ln3g, c.ln3b, lane);
#pragma unroll
        for (int j = 0; j < 4; ++j) { *(f32x4*)(c.x3 + (size_t)t * D + 4 * lane + 256 * j) = v[j]; u32x2 o; o.x = pk2(v[j][0], v[j][1]); o.y = pk2(v[j][2], v[j][3]);
            *(u32x2*)(c.XBF + (size_t)t * D + 4 * lane + 256 * j) = o; }
    }
}

template <int PH> __global__ void __launch_bounds__(512) ew_kernel(Params P, int layer) {
    __shared__ float scr[8 * 64 * 33];
    const Ctx c = make_ctx(P, layer); const int vb = blockIdx.x, nb = gridDim.x;
    if (PH == 0) phase_convert(c, scr, vb, nb);
    else if (PH == 1) phase_conv(c, vb, nb);
    else if (PH == 2) phase_attn_simple(c, vb, nb);
    else if (PH == 3) phase_scan1(c, vb, nb);
    else if (PH == 4) phase_attn_mix(c, vb, nb);
    else if (PH == 5) phase_scan2(c, vb, nb);
    else if (PH == 6) phase_ln1_router(c, vb, nb);
    else if (PH == 7) phase_scatter(c, vb, nb);
    else if (PH == 8) phase_combine_ln2(c, vb, nb);
    else if (PH == 9) phase_ln3(c, vb, nb);
}

extern "C" void kernel_launch(void* const* d_in, const int* in_sizes, int n_in, void* d_out, int out_size, void* d_ws, size_t ws_size, hipStream_t stream) {
    if (n_in != 30 || ws_size < WS_END) { fprintf(stderr, "kernel_launch: unexpected n_in %d or ws_size %zu\n", n_in, ws_size); return; }
    Params P{}; for (int i = 0; i < 30; ++i) P.in[i] = (const float*)d_in[i]; P.out = (float*)d_out; P.ws = (unsigned char*)d_ws;
    hipMemsetAsync((char*)d_ws + WS_CTL, 0, CTL_BYTES, stream);
    const int G = 1024;
    for (int l = 0; l < 2; ++l) {
        ew_kernel<0><<<G, 512, 0, stream>>>(P, l);
        sgemm_kernel<JobInproj><<<JobInproj::MAXU * 8, 256, 0, stream>>>(P, l);
        ew_kernel<1><<<G, 512, 0, stream>>>(P, l);
        ew_kernel<2><<<G, 512, 0, stream>>>(P, l);
        sgemm_kernel<JobGate><<<JobGate::MAXU * 8, 256, 0, stream>>>(P, l);
        ew_kernel<3><<<512, 512, 0, stream>>>(P, l);
        ew_kernel<4><<<G, 512, 0, stream>>>(P, l);
        ew_kernel<5><<<512, 512, 0, stream>>>(P, l);
        sgemm_kernel<JobY><<<JobY::MAXU * 8, 256, 0, stream>>>(P, l);
        sgemm_kernel<JobOut><<<JobOut::MAXU * 8, 256, 0, stream>>>(P, l);
        ew_kernel<6><<<G, 512, 0, stream>>>(P, l);
        ew_kernel<7><<<G, 512, 0, stream>>>(P, l);
        sgemm_kernel<JobMoeGU><<<JobMoeGU::MAXU * 8, 256, 0, stream>>>(P, l);
        sgemm_kernel<JobMoeD><<<JobMoeD::MAXU * 8, 256, 0, stream>>>(P, l);
        ew_kernel<8><<<G, 512, 0, stream>>>(P, l);
        sgemm_kernel<JobPle><<<JobPle::MAXU * 8, 256, 0, stream>>>(P, l);
        ew_kernel<9><<<G, 512, 0, stream>>>(P, l);
    }
}
```

```cpp
#include <hip/hip_runtime.h>
#include <stdint.h>
#include <stdio.h>

typedef unsigned short bf16_t;
typedef float f32x4 __attribute__((ext_vector_type(4)));
typedef unsigned u32x4 __attribute__((ext_vector_type(4)));
typedef unsigned u32x2 __attribute__((ext_vector_type(2)));

constexpr int NB = 4, SEQ = 4096, T = NB * SEQ, D = 1024, NIN = 8704, NE = 32, TOPK = 4, PLED = 256;
constexpr int NSLOT = T * TOPK + NE * 256;
constexpr float ALPHA = 1.41421356237309515f;
constexpr float LN_EPS = 1e-5f;
constexpr int KP = 1280;
constexpr int KC = 1536;

constexpr size_t MiB = 1u << 20;
constexpr size_t WS_CTL = 0, CTL_BYTES = 1 * MiB;
constexpr size_t WS_SEG = 1 * MiB, WS_ROUTE = 3 * MiB, WS_LSE = 4 * MiB;
constexpr size_t WS_WIN = 6 * MiB, WS_WG = 23 * MiB, WS_WCAT = 24 * MiB, WS_WOUT = 27 * MiB, WS_WPLE = 29 * MiB, WS_WGU = 32 * MiB, WS_WD = 160 * MiB;
constexpr size_t WS_XA = 224 * MiB, WS_V = 288 * MiB, WS_XBF = 352 * MiB, WS_ACAT2 = 384 * MiB, WS_R = 424 * MiB, WS_END = 856 * MiB;
constexpr size_t R_XR = 0, R_GYR = 32 * MiB, R_QKV = 64 * MiB, R_GR = 208 * MiB, R_GB = 240 * MiB, R_OG = 272 * MiB, R_ACAT = 320 * MiB, R_MERGED = 368 * MiB, R_XC = 400 * MiB;
constexpr size_t R_AA = 64 * MiB, R_BX = 128 * MiB;
constexpr size_t R_XG = 0, R_H = 144 * MiB, R_YB = 288 * MiB;
constexpr int CW_CNT = 1024, CW_CUR = 1024 + 64;

struct Params { const float* in[30]; float* out; unsigned char* ws; };

__device__ __forceinline__ float bf2f(bf16_t h) { return __uint_as_float((unsigned)h << 16); }
__device__ __forceinline__ unsigned f2bf(float f) { unsigned u = __float_as_uint(f); return (u + 0x7fffu + ((u >> 16) & 1u)) >> 16; }
__device__ __forceinline__ unsigned pk2(float lo, float hi) { return f2bf(lo) | (f2bf(hi) << 16); }
__device__ __forceinline__ float sigmoidf_(float x) { return __builtin_amdgcn_rcpf(1.f + __expf(-x)); }
__device__ __forceinline__ float gelu_tanh(float x) { const float u = 0.7978845608028654f * (x + 0.044715f * x * x * x); const float e = __expf(2.f * u); const float th = 1.f - 2.f / (e + 1.f); return 0.5f * x * (1.f + th); }
__device__ __forceinline__ float wave_sum(float v) {
#pragma unroll
    for (int o = 1; o < 64; o <<= 1) v += __shfl_xor(v, o);
    return v;
}

__device__ __forceinline__ int tid_opaque() { int t = threadIdx.x; asm volatile("" : "+v"(t)); return t; }
struct Ctx {
    typedef const __attribute__((address_space(4))) Params* KP;
    KP P; int layer;
    __device__ __forceinline__ explicit Ctx(int l) : layer(l) { KP k = (KP)__builtin_amdgcn_kernarg_segment_ptr(); asm volatile("" : "+s"(k)); P = k; }
#define WSP(T_, off) ((T_*)(P->ws + (off)))
    __device__ __forceinline__ float* XAbuf() const { return WSP(float, WS_XA); }
    __device__ __forceinline__ const float* xin() const { return layer == 0 ? P->in[0] : (const float*)XAbuf(); }
    __device__ __forceinline__ float* x1() const { return layer == 0 ? XAbuf() : P->out; }
    __device__ __forceinline__ float* x2() const { return layer == 0 ? P->out : XAbuf(); }
    __device__ __forceinline__ float* x3() const { return layer == 0 ? XAbuf() : P->out; }
    __device__ __forceinline__ float* V() const { return WSP(float, WS_V); }
    __device__ __forceinline__ const float* p() const { return P->in[1] + (size_t)layer * T * PLED; }
    __device__ __forceinline__ const float* w_in() const { return P->in[2] + (size_t)layer * D * NIN; }
    __device__ __forceinline__ const float* conv_w() const { return P->in[3] + layer * 4 * D; }
    __device__ __forceinline__ const float* conv_b() const { return P->in[4] + layer * D; }
    __device__ __forceinline__ const float* w_rg() const { return P->in[5] + (size_t)layer * 4 * 256 * 256; }
    __device__ __forceinline__ const float* b_rg() const { return P->in[6] + layer * D; }
    __device__ __forceinline__ const float* w_ig() const { return P->in[7] + (size_t)layer * 4 * 256 * 256; }
    __device__ __forceinline__ const float* b_ig() const { return P->in[8] + layer * D; }
    __device__ __forceinline__ const float* lam() const { return P->in[9] + layer * D; }
    __device__ __forceinline__ const float* w_rnn_out() const { return P->in[10] + (size_t)layer * D * D; }
    __device__ __forceinline__ const float* w_att_out() const { return P->in[11] + (size_t)layer * 512 * D; }
    __device__ __forceinline__ const float* w_out() const { return P->in[12] + (size_t)layer * D * D; }
    __device__ __forceinline__ const float* ln1g() const { return P->in[13] + layer * D; }
    __device__ __forceinline__ const float* ln1b() const { return P->in[14] + layer * D; }
    __device__ __forceinline__ const float* w_router() const { return P->in[15] + (size_t)layer * D * NE; }
    __device__ __forceinline__ const float* b_router() const { return P->in[16] + layer * NE; }
    __device__ __forceinline__ const float* w_gate() const { return P->in[17] + (size_t)layer * NE * D * D; }
    __device__ __forceinline__ const float* b_gate() const { return P->in[18] + (size_t)layer * NE * D; }
    __device__ __forceinline__ const float* w_up() const { return P->in[19] + (size_t)layer * NE * D * D; }
    __device__ __forceinline__ const float* b_up() const { return P->in[20] + (size_t)layer * NE * D; }
    __device__ __forceinline__ const float* w_down() const { return P->in[21] + (size_t)layer * NE * D * D; }
    __device__ __forceinline__ const float* b_down() const { return P->in[22] + (size_t)layer * NE * D; }
    __device__ __forceinline__ const float* ln2g() const { return P->in[23] + layer * D; }
    __device__ __forceinline__ const float* ln2b() const { return P->in[24] + layer * D; }
    __device__ __forceinline__ const float* w_ple() const { return P->in[25] + (size_t)layer * PLED * D; }
    __device__ __forceinline__ const float* w_pg() const { return P->in[26] + (size_t)layer * D * D; }
    __device__ __forceinline__ const float* b_pg() const { return P->in[27] + layer * D; }
    __device__ __forceinline__ const float* ln3g() const { return P->in[28] + layer * D; }
    __device__ __forceinline__ const float* ln3b() const { return P->in[29] + layer * D; }
    __device__ __forceinline__ bf16_t* WIN() const { return WSP(bf16_t, WS_WIN); }
    __device__ __forceinline__ bf16_t* WG() const { return WSP(bf16_t, WS_WG); }
    __device__ __forceinline__ bf16_t* WCAT() const { return WSP(bf16_t, WS_WCAT); }
    __device__ __forceinline__ bf16_t* WOUT() const { return WSP(bf16_t, WS_WOUT); }
    __device__ __forceinline__ bf16_t* WPLE() const { return WSP(bf16_t, WS_WPLE); }
    __device__ __forceinline__ bf16_t* WGU() const { return WSP(bf16_t, WS_WGU); }
    __device__ __forceinline__ bf16_t* WD() const { return WSP(bf16_t, WS_WD); }
    __device__ __forceinline__ bf16_t* XBF() const { return WSP(bf16_t, WS_XBF); }
    __device__ __forceinline__ bf16_t* ACAT2() const { return WSP(bf16_t, WS_ACAT2); }
    __device__ __forceinline__ bf16_t* XR() const { return WSP(bf16_t, WS_R + R_XR); }
    __device__ __forceinline__ bf16_t* GYR() const { return WSP(bf16_t, WS_R + R_GYR); }
    __device__ __forceinline__ bf16_t* QKV() const { return WSP(bf16_t, WS_R + R_QKV); }
    __device__ __forceinline__ bf16_t* GR() const { return WSP(bf16_t, WS_R + R_GR); }
    __device__ __forceinline__ bf16_t* GB() const { return WSP(bf16_t, WS_R + R_GB); }
    __device__ __forceinline__ bf16_t* OG() const { return WSP(bf16_t, WS_R + R_OG); }
    __device__ __forceinline__ bf16_t* ACAT() const { return WSP(bf16_t, WS_R + R_ACAT); }
    __device__ __forceinline__ bf16_t* MERGED() const { return WSP(bf16_t, WS_R + R_MERGED); }
    __device__ __forceinline__ bf16_t* XC() const { return WSP(bf16_t, WS_R + R_XC); }
    __device__ __forceinline__ bf16_t* XG() const { return WSP(bf16_t, WS_R + R_XG); }
    __device__ __forceinline__ bf16_t* H() const { return WSP(bf16_t, WS_R + R_H); }
    __device__ __forceinline__ bf16_t* YB() const { return WSP(bf16_t, WS_R + R_YB); }
    __device__ __forceinline__ float* AA() const { return WSP(float, WS_R + R_AA); }
    __device__ __forceinline__ float* BX() const { return WSP(float, WS_R + R_BX); }
    __device__ __forceinline__ float* SEGS() const { return WSP(float, WS_SEG); }
    __device__ __forceinline__ float* LSE() const { return WSP(float, WS_LSE); }
    __device__ __forceinline__ float* SP() const { return WSP(float, WS_ROUTE + 768 * 1024) + layer * D; }
    __device__ __forceinline__ int* TOPE() const { return WSP(int, WS_ROUTE); }
    __device__ __forceinline__ float* TOPG() const { return WSP(float, WS_ROUTE + 256 * 1024); }
    __device__ __forceinline__ int* SLOT() const { return WSP(int, WS_ROUTE + 512 * 1024); }
    __device__ __forceinline__ unsigned* CNT() const { return WSP(unsigned, WS_CTL) + CW_CNT + 128 * layer; }
    __device__ __forceinline__ unsigned* CUR() const { return WSP(unsigned, WS_CTL) + CW_CUR + 128 * layer; }
#undef WSP
};
__device__ __forceinline__ int dil_of(int g) { return 1 << (2 * g); }
__device__ __forceinline__ int split_row(int g, int tok) { const int d = dil_of(g), b = tok / SEQ, s = tok % SEQ; return (b * d + (s % d)) * (SEQ / d) + s / d; }
__device__ __forceinline__ int token_of_split(int g, int sr) { const int d = dil_of(g), L = SEQ / d, bd = sr / L, l = sr % L; return (bd / d) * SEQ + l * d + (bd % d); }

struct CvtJob { const float* W; int lds; int K, N; bf16_t* dst; int ldd; int mode, ty; };
__device__ __forceinline__ int cvt_items(const CvtJob& j) { return (j.K / 64) * (j.N / 32); }
__device__ __forceinline__ CvtJob cvt_job(const Ctx& c, int j) {
    CvtJob r;
    if (j == 0) { r = {c.w_in(), NIN, D, 6656, c.WIN(), D, 0, 0}; }
    else if (j == 1) { r = {c.w_in() + 6656, NIN, D, 1024, c.WIN() + (size_t)6656 * D, D, 1, 0}; }
    else if (j == 2) { r = {c.w_in() + 7680, NIN, D, 1024, c.WIN() + (size_t)6656 * D, D, 1, 1}; }
    else if (j < 11) { const int q = j - 3, nb = q >> 1, gt = q & 1; r = {(gt ? c.w_ig() : c.w_rg()) + (size_t)nb * 65536, 256, 256, 256, c.WG() + (size_t)nb * 512 * 256, 256, 1, gt}; }
    else if (j == 11) { r = {c.w_rnn_out(), D, D, D, c.WCAT(), KC, 0, 0}; }
    else if (j == 12) { r = {c.w_att_out(), D, 512, D, c.WCAT() + 1024, KC, 0, 0}; }
    else if (j == 13) { r = {c.w_out(), D, D, D, c.WOUT(), D, 0, 0}; }
    else if (j == 14) { r = {c.w_ple(), D, PLED, D, c.WPLE(), KP, 0, 0}; }
    else if (j == 15) { r = {c.w_pg(), D, D, D, c.WPLE() + 256, KP, 0, 0}; }
    else { const int q = j - 16, e = q / 3, w = q % 3;
        if (w == 0) r = {c.w_gate() + (size_t)e * D * D, D, D, D, c.WGU() + (size_t)e * 2048 * D, D, 1, 0};
        else if (w == 1) r = {c.w_up() + (size_t)e * D * D, D, D, D, c.WGU() + (size_t)e * 2048 * D, D, 1, 1};
        else r = {c.w_down() + (size_t)e * D * D, D, D, D, c.WD() + (size_t)e * D * D, D, 0, 0}; }
    return r;
}
constexpr int CVT_NJOBS = 16 + 3 * NE;
__device__ __forceinline__ void cvt_item(const CvtJob& J, int item, float* scr, int lane) {
    const int nblk = J.N / 32, kb = item / nblk, nb = item % nblk, k0 = 64 * kb, n0 = 32 * nb;
#pragma unroll 8
    for (int i = 0; i < 32; ++i) { const int kk = 2 * i + (lane >> 5); scr[kk * 33 + (lane & 31)] = J.W[(size_t)(k0 + kk) * J.lds + n0 + (lane & 31)]; }
    __builtin_amdgcn_s_waitcnt(0xc07f); asm volatile("" ::: "memory");
    const int cch = lane & 7;
    const int r0 = J.mode ? ((n0 >> 7) * 256 + J.ty * 128 + (n0 & 127)) : n0;
#pragma unroll
    for (int j = 0; j < 4; ++j) { const int n = (lane >> 3) + 8 * j; const float* s = scr + (8 * cch) * 33 + n;
        u32x4 o; o.x = pk2(s[0 * 33], s[1 * 33]); o.y = pk2(s[2 * 33], s[3 * 33]); o.z = pk2(s[4 * 33], s[5 * 33]); o.w = pk2(s[6 * 33], s[7 * 33]);
        *(u32x4*)(J.dst + (size_t)(r0 + n) * J.ldd + k0 + 8 * cch) = o; }
    __builtin_amdgcn_s_waitcnt(0xc07f); asm volatile("" ::: "memory");
}
__device__ __forceinline__ void phase_convert(const Ctx& c, float* scr_all, int vb, int nb) {
    const int tid = tid_opaque();
    const int lane = tid & 63, wave = tid >> 6, nwv = blockDim.x >> 6;
    float* scr = scr_all + wave * (64 * 33);
    const int gw = vb * nwv + wave, NGW = nb * nwv;
    int base = 0;
    for (int j = 0; j < CVT_NJOBS; ++j) {
        const CvtJob J = cvt_job(c, j); const int ni = cvt_items(J);
        int first = gw - (base % NGW); if (first < 0) first += NGW;
        for (int it = first; it < ni; it += NGW) cvt_item(J, it, scr, lane);
        base += ni;
    }
    if (vb == 0) for (int i = tid; i < D; i += blockDim.x) c.SP()[i] = log1pf(__expf(-c.lam()[i]));
    if (c.layer == 0) {
        for (size_t i = (size_t)(vb * blockDim.x + tid); i < (size_t)T * D / 4; i += (size_t)nb * blockDim.x) {
            const f32x4 v = *(const f32x4*)(c.xin() + 4 * i); u32x2 o; o.x = pk2(v.x, v.y); o.y = pk2(v.z, v.w); *(u32x2*)(c.XBF() + 4 * i) = o; }
    }
    for (size_t i = (size_t)(vb * blockDim.x + tid); i < (size_t)T * PLED / 4; i += (size_t)nb * blockDim.x) {
        const f32x4 v = *(const f32x4*)(c.p() + 4 * i); u32x2 o; o.x = pk2(v.x, v.y); o.y = pk2(v.z, v.w);
        const size_t row = (4 * i) / PLED, col = (4 * i) % PLED; *(u32x2*)(c.ACAT2() + row * KP + col) = o; }
}

struct Unit { int pm, pn, e; };

struct JobInproj {
    static constexpr int K = 1024, KMID = 0, MAXU = 64 * 34, LDA = D, LDB = D;
    Ctx c; __device__ JobInproj(const Ctx& c_) : c(c_) {}
    __device__ bool unit(int idx, Unit& u, const bf16_t*& A, const bf16_t*& Bt) const {
        if (idx >= MAXU) return false; u.pm = idx % 64; u.pn = idx / 64; u.e = 0;
        A = c.XBF() + (size_t)u.pm * 256 * D; Bt = c.WIN() + (size_t)u.pn * 256 * D; return true; }
    __device__ void mid(const Unit&, int, int, f32x4&, f32x4&) const {}
    __device__ void epi(const Unit& u, int row, int col, f32x4 v0, f32x4 v1) const {
        if (col < 1024) { st4(c.XR() + (size_t)row * D + col, v0); st4(c.XR() + (size_t)row * D + col + 128, v1); }
        else if (col < 2048) { const int cc = col - 1024; f32x4 a, b;
            for (int j = 0; j < 4; ++j) { a[j] = gelu_tanh(v0[j]); b[j] = gelu_tanh(v1[j]); }
            st4(c.GYR() + (size_t)row * D + cc, a); st4(c.GYR() + (size_t)row * D + cc + 128, b); }
        else if (col < 6656) { const int q = col - 2048, which = q / 1536, g = (q % 1536) / 512, cc = q % 512;
            const float sc = which == 0 ? 0.125f : 1.f; bf16_t* dst = c.QKV() + (size_t)(g * 3 + which) * T * 512 + (size_t)split_row(g, row) * 512 + cc;
            st4(dst, v0 * sc); st4(dst + 128, v1 * sc); }
        else { const int cc = (col - 6656) / 256 * 128 + (col - 6656) % 256;
            f32x4 r, s; for (int j = 0; j < 4; ++j) { const float sa = sigmoidf_(v0[j]), sb = sigmoidf_(v1[j]); r[j] = sa / sb; s[j] = sb; }
            st4(c.GR() + (size_t)row * D + cc, r); st4(c.GB() + (size_t)row * D + cc, s); }
    }
    static __device__ __forceinline__ void st4(bf16_t* p, f32x4 v) { u32x2 o; o.x = pk2(v[0], v[1]); o.y = pk2(v[2], v[3]); *(u32x2*)p = o; }
};
struct JobGate {
    static constexpr int K = 256, KMID = 0, MAXU = 64 * 8, LDA = D, LDB = 256;
    Ctx c; __device__ JobGate(const Ctx& c_) : c(c_) {}
    __device__ bool unit(int idx, Unit& u, const bf16_t*& A, const bf16_t*& Bt) const {
        if (idx >= MAXU) return false; u.pm = idx % 64; u.pn = idx / 64; u.e = 0;
        A = c.XC() + (size_t)u.pm * 256 * D + (u.pn >> 1) * 256; Bt = c.WG() + (size_t)u.pn * 256 * 256; return true; }
    __device__ void mid(const Unit&, int, int, f32x4&, f32x4&) const {}
    __device__ void epi(const Unit& u, int row, int col, f32x4 v0, f32x4 v1) const {
        const int ch = (col >> 8) * 128 + (col & 255);
        f32x4 a, bx;
        for (int j = 0; j < 4; ++j) { const int cc = ch + j;
            const float r = sigmoidf_(v0[j] + c.b_rg()[cc]), ig = sigmoidf_(v1[j] + c.b_ig()[cc]);
            const float la = -8.f * r * c.SP()[cc]; const float av = __expf(la);
            const float xc = bf2f(c.XC()[(size_t)row * D + cc]);
            const float x2_ = 2.f * la; const float om = -x2_ * (1.f + x2_ * (0.5f + x2_ * (0.16666667f + x2_ * (0.041666668f + x2_ * 0.0083333338f))));
            a[j] = av; bx[j] = sqrtf(om) * (ig * xc); }
        *(f32x4*)(c.AA() + (size_t)row * D + ch) = a; *(f32x4*)(c.BX() + (size_t)row * D + ch) = bx;
    }
};
struct JobY {
    static constexpr int K = KC, KMID = 1024, MAXU = 64 * 4, LDA = KC, LDB = KC;
    Ctx c; __device__ JobY(const Ctx& c_) : c(c_) {}
    __device__ bool unit(int idx, Unit& u, const bf16_t*& A, const bf16_t*& Bt) const {
        if (idx >= MAXU) return false; u.pm = idx % 64; u.pn = idx / 64; u.e = 0;
        A = c.ACAT() + (size_t)u.pm * 256 * KC; Bt = c.WCAT() + (size_t)u.pn * 256 * KC; return true; }
    __device__ void mid(const Unit&, int row, int col, f32x4& v0, f32x4& v1) const {
        for (int j = 0; j < 4; ++j) { v0[j] *= bf2f(c.GR()[(size_t)row * D + col + j]); v1[j] *= bf2f(c.GR()[(size_t)row * D + col + 128 + j]); } }
    __device__ void epi(const Unit&, int row, int col, f32x4 v0, f32x4 v1) const {
        for (int j = 0; j < 4; ++j) { v0[j] *= bf2f(c.GB()[(size_t)row * D + col + j]); v1[j] *= bf2f(c.GB()[(size_t)row * D + col + 128 + j]); }
        JobInproj::st4(c.MERGED() + (size_t)row * D + col, v0); JobInproj::st4(c.MERGED() + (size_t)row * D + col + 128, v1); }
};
struct JobOut {
    static constexpr int K = 1024, KMID = 0, MAXU = 64 * 4, LDA = D, LDB = D;
    Ctx c; __device__ JobOut(const Ctx& c_) : c(c_) {}
    __device__ bool unit(int idx, Unit& u, const bf16_t*& A, const bf16_t*& Bt) const {
        if (idx >= MAXU) return false; u.pm = idx % 64; u.pn = idx / 64; u.e = 0;
        A = c.MERGED() + (size_t)u.pm * 256 * D; Bt = c.WOUT() + (size_t)u.pn * 256 * D; return true; }
    __device__ void mid(const Unit&, int, int, f32x4&, f32x4&) const {}
    __device__ void epi(const Unit&, int row, int col, f32x4 v0, f32x4 v1) const {
        const f32x4 x0 = *(const f32x4*)(c.xin() + (size_t)row * D + col), x1 = *(const f32x4*)(c.xin() + (size_t)row * D + col + 128);
        *(f32x4*)(c.V() + (size_t)row * D + col) = x0 * ALPHA + v0; *(f32x4*)(c.V() + (size_t)row * D + col + 128) = x1 * ALPHA + v1; }
};
__device__ __forceinline__ bool moe_tile(const unsigned* CNT, int mt, int& e) {
    int acc = 0;
    for (int i = 0; i < NE; ++i) { const int nt = (int)((CNT[i] + 255u) >> 8); if (mt < acc + nt) { e = i; return true; } acc += nt; }
    return false;
}
struct JobMoeGU {
    static constexpr int K = 1024, KMID = 0, MAXU = 288 * 8, LDA = D, LDB = D;
    Ctx c; __device__ JobMoeGU(const Ctx& c_) : c(c_) {}
    __device__ bool unit(int idx, Unit& u, const bf16_t*& A, const bf16_t*& Bt) const {
        u.pm = idx / 8; u.pn = idx % 8; if (u.pm >= 288 || !moe_tile(c.CNT(), u.pm, u.e)) return false;
        A = c.XG() + (size_t)u.pm * 256 * D; Bt = c.WGU() + (size_t)u.e * 2048 * D + (size_t)u.pn * 256 * D; return true; }
    __device__ void mid(const Unit&, int, int, f32x4&, f32x4&) const {}
    __device__ void epi(const Unit& u, int row, int col, f32x4 v0, f32x4 v1) const {
        const int ch = (col >> 8) * 128 + (col & 255); f32x4 h;
        for (int j = 0; j < 4; ++j) { float g = v0[j] + c.b_gate()[u.e * D + ch + j], up = v1[j] + c.b_up()[u.e * D + ch + j];
            g = fminf(g, 7.f); up = fminf(fmaxf(up, -7.f), 7.f); h[j] = (up + 1.f) * (g * sigmoidf_(1.702f * g)); }
        JobInproj::st4(c.H() + (size_t)row * D + ch, h); }
};
struct JobMoeD {
    static constexpr int K = 1024, KMID = 0, MAXU = 288 * 4, LDA = D, LDB = D;
    Ctx c; __device__ JobMoeD(const Ctx& c_) : c(c_) {}
    __device__ bool unit(int idx, Unit& u, const bf16_t*& A, const bf16_t*& Bt) const {
        u.pm = idx / 4; u.pn = idx % 4; if (u.pm >= 288 || !moe_tile(c.CNT(), u.pm, u.e)) return false;
        A = c.H() + (size_t)u.pm * 256 * D; Bt = c.WD() + (size_t)u.e * D * D + (size_t)u.pn * 256 * D; return true; }
    __device__ void mid(const Unit&, int, int, f32x4&, f32x4&) const {}
    __device__ void epi(const Unit& u, int row, int col, f32x4 v0, f32x4 v1) const {
        const f32x4 b0 = *(const f32x4*)(c.b_down() + u.e * D + col), b1 = *(const f32x4*)(c.b_down() + u.e * D + col + 128);
        JobInproj::st4(c.YB() + (size_t)row * D + col, v0 + b0); JobInproj::st4(c.YB() + (size_t)row * D + col + 128, v1 + b1); }
};
struct JobPle {
    static constexpr int K = KP, KMID = 256, MAXU = 64 * 4, LDA = KP, LDB = KP;
    Ctx c; __device__ JobPle(const Ctx& c_) : c(c_) {}
    __device__ bool unit(int idx, Unit& u, const bf16_t*& A, const bf16_t*& Bt) const {
        if (idx >= MAXU) return false; u.pm = idx % 64; u.pn = idx / 64; u.e = 0;
        A = c.ACAT2() + (size_t)u.pm * 256 * KP; Bt = c.WPLE() + (size_t)u.pn * 256 * KP; return true; }
    __device__ void mid(const Unit&, int row, int col, f32x4& v0, f32x4& v1) const {
        *(f32x4*)(c.V() + (size_t)row * D + col) = v0; *(f32x4*)(c.V() + (size_t)row * D + col + 128) = v1; v0 = (f32x4){0.f, 0.f, 0.f, 0.f}; v1 = v0; }
    __device__ void epi(const Unit&, int row, int col, f32x4 v0, f32x4 v1) const {
        float* vp = c.V() + (size_t)row * D + col; const float* xp = c.x2() + (size_t)row * D + col;
        f32x4 l0 = *(f32x4*)vp, l1 = *(f32x4*)(vp + 128); const f32x4 x0 = *(const f32x4*)xp, x1 = *(const f32x4*)(xp + 128);
        for (int j = 0; j < 4; ++j) { l0[j] = ALPHA * x0[j] + l0[j] * sigmoidf_(v0[j] + c.b_pg()[col + j]); l1[j] = ALPHA * x1[j] + l1[j] * sigmoidf_(v1[j] + c.b_pg()[col + 128 + j]); }
        *(f32x4*)vp = l0; *(f32x4*)(vp + 128) = l1; }
};

#if 0
template <class Job> __global__ void __launch_bounds__(256) sgemm_kernel(Params P, int layer) {
    __shared__ float As[16][129]; __shared__ float Bs[16][65];
    const Ctx c(P, layer); const Job J(c);
    const int idx = blockIdx.x >> 3, sub = blockIdx.x & 7, rh = sub >> 2, cs = sub & 3;
    Unit u; const bf16_t *A, *Bt; constexpr int lda = Job::LDA, ldb = Job::LDB;
    if (!J.unit(idx, u, A, Bt)) return;
    const int tid = threadIdx.x, cg = tid & 7, rg = tid >> 3;
    A += (size_t)rh * 128 * lda;
    f32x4 acc0[4], acc1[4];
    for (int i = 0; i < 4; ++i) { acc0[i] = (f32x4){0.f, 0.f, 0.f, 0.f}; acc1[i] = acc0[i]; }
    const int row0 = u.pm * 256 + rh * 128 + rg * 4, col0 = u.pn * 256 + cs * 32 + cg * 4;
    for (int k0 = 0; k0 < Job::K; k0 += 16) {
        if (Job::KMID > 0 && k0 == Job::KMID) { for (int i = 0; i < 4; ++i) J.mid(u, row0 + i, col0, acc0[i], acc1[i]); }
        { const int r = tid >> 1, kq = (tid & 1) * 8; const u32x4 v = *(const u32x4*)(A + (size_t)r * lda + k0 + kq);
          for (int j = 0; j < 4; ++j) { As[kq + 2 * j][r] = __uint_as_float(v[j] << 16); As[kq + 2 * j + 1][r] = __uint_as_float(v[j] & 0xffff0000u); } }
        { const int jn = tid >> 2, kq = (tid & 3) * 4; const int n = (jn < 32) ? cs * 32 + jn : 128 + cs * 32 + (jn - 32);
          const u32x2 v = *(const u32x2*)(Bt + (size_t)n * ldb + k0 + kq);
          for (int j = 0; j < 2; ++j) { Bs[kq + 2 * j][jn] = __uint_as_float(v[j] << 16); Bs[kq + 2 * j + 1][jn] = __uint_as_float(v[j] & 0xffff0000u); } }
        __syncthreads();
#pragma unroll
        for (int k = 0; k < 16; ++k) {
            float a[4], b0[4], b1[4];
            for (int i = 0; i < 4; ++i) a[i] = As[k][rg * 4 + i];
            for (int j = 0; j < 4; ++j) { b0[j] = Bs[k][cg * 4 + j]; b1[j] = Bs[k][32 + cg * 4 + j]; }
            for (int i = 0; i < 4; ++i) for (int j = 0; j < 4; ++j) { acc0[i][j] += a[i] * b0[j]; acc1[i][j] += a[i] * b1[j]; }
        }
        __syncthreads();
    }
    for (int i = 0; i < 4; ++i) J.epi(u, row0 + i, col0, acc0[i], acc1[i]);
}

#endif

namespace pg8 {
#define PG8_LAS __attribute__((address_space(3)))
typedef short bf16x8 __attribute__((ext_vector_type(8)));
constexpr int BM = 256, BK = 64, HALF = 128, HTB = HALF * BK * 2, STAGE_BYTES = 8 * HTB;
__host__ __device__ __forceinline__ int lds_byte(int r, int c) { const int st = (r >> 4) * 2 + (c >> 5), rr = r & 15, cc = c & 31, ob = rr * 64 + cc * 2; return st * 1024 + (ob ^ (((ob >> 9) & 1) << 5)); }
__host__ __device__ __forceinline__ void stage_rc(int b, int& R, int& C) { const int st = b / 1024, sb = b % 1024, swz = sb ^ (((sb >> 9) & 1) << 5); R = (st >> 1) * 16 + swz / 64; C = (st & 1) * 32 + (swz % 64) / 2; }
__device__ __forceinline__ const char* uni_ptr(const void* p) { const unsigned long long v = (unsigned long long)p; const unsigned lo = __builtin_amdgcn_readfirstlane((unsigned)v), hi = __builtin_amdgcn_readfirstlane((unsigned)(v >> 32)); return (const char*)(((unsigned long long)hi << 32) | lo); }

template <class Job> __device__ __forceinline__ bool get_unit(const Job& J, int idx, Unit& u, const char*& a, const char*& b) {
    const bf16_t *A, *Bt; if (!J.unit(idx, u, A, Bt)) return false; a = uni_ptr(A); b = uni_ptr(Bt); return true; }
template <class Job> __device__ __forceinline__ void run_epi(const Job& J, const Unit& u, const f32x4 (&acc)[2][2][4][2], int wr, int wc, int fr, int fq) {
#pragma unroll
    for (int ai = 0; ai < 2; ++ai)
#pragma unroll
        for (int m = 0; m < 4; ++m) {
#pragma unroll
            for (int n = 0; n < 2; ++n) J.epi(u, u.pm * BM + ai * HALF + wr * 64 + m * 16 + fr, u.pn * BM + wc * 32 + n * 16 + fq * 4, acc[ai][0][m][n], acc[ai][1][m][n]);
            asm volatile("" ::: "memory"); }
}
template <class Job> __device__ __forceinline__ void run_mid(const Job& J, const Unit& u, f32x4 (&acc)[2][2][4][2], int wr, int wc, int fr, int fq) {
#pragma unroll
    for (int ai = 0; ai < 2; ++ai)
#pragma unroll
        for (int m = 0; m < 4; ++m) {
#pragma unroll
            for (int n = 0; n < 2; ++n) J.mid(u, u.pm * BM + ai * HALF + wr * 64 + m * 16 + fr, u.pn * BM + wc * 32 + n * 16 + fq * 4, acc[ai][0][m][n], acc[ai][1][m][n]);
            asm volatile("" ::: "memory"); }
}

template <class Job>
__device__ __forceinline__ void gemm_phase(PG8_LAS unsigned char* lds, const Job& J, const int c, const int G) {
    int tid_ = threadIdx.x; asm volatile("" : "+v"(tid_));
    const int tid = tid_, wid = __builtin_amdgcn_readfirstlane(tid >> 6), lane = tid & 63, wr = wid >> 2, wc = wid & 3, fr = lane & 15, fq = lane >> 4;
    constexpr int K = Job::K, nt = K / BK, LDA = Job::LDA, LDB = Job::LDB, TM = Job::KMID / BK;
    static_assert(K % 128 == 0 && K >= 256 && (TM % 2) == 0, "K-loop shape");
    unsigned voffA[2], voffB[2];
#pragma unroll
    for (int i = 0; i < 2; ++i) { int R, C; stage_rc(tid * 16 + i * 8192, R, C); voffA[i] = (unsigned)(R * LDA + C) * 2u; voffB[i] = (unsigned)(R * LDB + C) * 2u; }
    constexpr size_t kstep = (size_t)(BK * 2), hstepA = (size_t)HALF * LDA * 2, hstepB = (size_t)HALF * LDB * 2;
    const unsigned ldsw = (unsigned)wid * 1024u;
    const int aoff = lds_byte(wr * 64 + fr, fq * 8), boff = lds_byte(wc * 32 + fr, fq * 8);
#define PG8_SA(b, h) (((b) * 2 + (h)) * HTB)
#define PG8_SB(b, h) ((4 + (b) * 2 + (h)) * HTB)
#define PG8_STAGE(bufoff, gbase, voff) do { _Pragma("unroll") for (int _i = 0; _i < 2; ++_i) \
        __builtin_amdgcn_global_load_lds((const unsigned*)((const char*)(gbase) + (voff)[_i]), (PG8_LAS unsigned*)(lds + (bufoff) + ldsw + _i * 8192), 16, 0, 0); } while (0)
#define PG8_LDA(dst, b, h) do { _Pragma("unroll") for (int m = 0; m < 4; ++m) _Pragma("unroll") for (int k = 0; k < 2; ++k) dst[m][k] = *(const PG8_LAS bf16x8*)(lds + PG8_SA(b, h) + aoff + m * 2048 + k * 1024); } while (0)
#define PG8_LDB(dst, b, h) do { _Pragma("unroll") for (int n = 0; n < 2; ++n) _Pragma("unroll") for (int k = 0; k < 2; ++k) dst[n][k] = *(const PG8_LAS bf16x8*)(lds + PG8_SB(b, h) + boff + n * 2048 + k * 1024); } while (0)
#define PG8_MMA(ai, bj, At, Bt) do { __builtin_amdgcn_s_setprio(1); _Pragma("unroll") for (int m = 0; m < 4; ++m) _Pragma("unroll") for (int n = 0; n < 2; ++n) _Pragma("unroll") for (int k = 0; k < 2; ++k) \
        acc[ai][bj][m][n] = __builtin_amdgcn_mfma_f32_16x16x32_bf16(Bt[n][k], At[m][k], acc[ai][bj][m][n], 0, 0, 0); __builtin_amdgcn_s_setprio(0); } while (0)
#define PG8_WAIT_V(n) asm volatile("s_waitcnt vmcnt(" #n ")" ::: "memory")
#define PG8_WAIT_L(n) asm volatile("s_waitcnt lgkmcnt(" #n ")" ::: "memory")
#define PG8_BAR __builtin_amdgcn_s_barrier()
#define PG8_SCHED __builtin_amdgcn_sched_barrier(0)
    Unit cur, nxt; int ui = 0; const char *cA, *cB;
    if (!get_unit(J, c, cur, cA, cB)) return;
    f32x4 acc[2][2][4][2];
#pragma unroll
    for (int a = 0; a < 2; ++a)
#pragma unroll
        for (int b = 0; b < 2; ++b)
#pragma unroll
            for (int m = 0; m < 4; ++m)
#pragma unroll
                for (int n = 0; n < 2; ++n) acc[a][b][m][n] = (f32x4){0.f, 0.f, 0.f, 0.f};
    bf16x8 At[4][2], B0[2][2], B1[2][2];
    PG8_STAGE(PG8_SB(0, 0), cB, voffB); PG8_STAGE(PG8_SB(0, 1), cB + hstepB, voffB); PG8_STAGE(PG8_SA(0, 0), cA, voffA); PG8_STAGE(PG8_SA(0, 1), cA + hstepA, voffA);
    if (wr == 1) PG8_BAR;
    PG8_WAIT_V(2); PG8_BAR;
    PG8_STAGE(PG8_SB(1, 0), cB + kstep, voffB); PG8_STAGE(PG8_SA(1, 0), cA + kstep, voffA); PG8_STAGE(PG8_SB(1, 1), cB + hstepB + kstep, voffB);
    PG8_WAIT_V(6); PG8_BAR;
    for (;;) {
        const char *nA, *nB;
        const bool has_next = get_unit(J, (ui + 1) * G + c, nxt, nA, nB);
        if (!has_next) { nA = cA; nB = cB; }
#define PG8_KBODY(t, last) do { \
            const char* a1 = cA + (size_t)((t) + 1) * kstep; \
            const char* a2 = (last) ? nA : cA + (size_t)((t) + 2) * kstep; const char* b2 = (last) ? nB : cB + (size_t)((t) + 2) * kstep; \
            const char* a3 = a2 + kstep; const char* b3 = b2 + kstep; \
              \
            PG8_LDB(B0, 0, 0); PG8_LDB(B1, 0, 1); PG8_SCHED; PG8_LDA(At, 0, 0); PG8_STAGE(PG8_SA(1, 1), a1 + hstepA, voffA); \
            PG8_WAIT_V(8); PG8_WAIT_L(0); PG8_BAR; PG8_MMA(0, 0, At, B0); PG8_MMA(0, 1, At, B1); PG8_BAR; PG8_SCHED; \
              \
            PG8_LDA(At, 0, 1); PG8_STAGE(PG8_SB(0, 0), b2, voffB); PG8_STAGE(PG8_SB(0, 1), b2 + hstepB, voffB); PG8_STAGE(PG8_SA(0, 0), a2, voffA); \
            PG8_WAIT_V(8); PG8_WAIT_L(0); PG8_BAR; PG8_MMA(1, 0, At, B0); PG8_MMA(1, 1, At, B1); PG8_BAR; PG8_SCHED; \
              \
            PG8_LDB(B0, 1, 0); PG8_LDB(B1, 1, 1); PG8_SCHED; PG8_LDA(At, 1, 0); PG8_STAGE(PG8_SA(0, 1), a2 + hstepA, voffA); \
            PG8_WAIT_V(8); PG8_WAIT_L(0); PG8_BAR; PG8_MMA(0, 0, At, B0); PG8_MMA(0, 1, At, B1); PG8_BAR; PG8_SCHED; \
              \
            PG8_LDA(At, 1, 1); PG8_STAGE(PG8_SB(1, 0), b3, voffB); PG8_STAGE(PG8_SB(1, 1), b3 + hstepB, voffB); PG8_STAGE(PG8_SA(1, 0), a3, voffA); \
            PG8_WAIT_V(8); PG8_WAIT_L(0); PG8_BAR; PG8_MMA(1, 0, At, B0); PG8_MMA(1, 1, At, B1); PG8_BAR; PG8_SCHED; } while (0)
        if constexpr (TM > 0) {
#pragma unroll 1
            for (int t = 0; t < TM; t += 2) PG8_KBODY(t, false);
            run_mid(J, cur, acc, wr, wc, fr, fq); PG8_WAIT_V(0);
#pragma unroll 1
            for (int t = TM; t < nt; t += 2) PG8_KBODY(t, t == nt - 2);
        } else {
#pragma unroll 1
            for (int t = 0; t < nt; t += 2) PG8_KBODY(t, t == nt - 2);
        }
#undef PG8_KBODY
        if (wr == 0) PG8_BAR;
        run_epi(J, cur, acc, wr, wc, fr, fq);
        if (!has_next) break;
#pragma unroll
        for (int a = 0; a < 2; ++a)
#pragma unroll
            for (int b = 0; b < 2; ++b)
#pragma unroll
                for (int m = 0; m < 4; ++m)
#pragma unroll
                    for (int n = 0; n < 2; ++n) acc[a][b][m][n] = (f32x4){0.f, 0.f, 0.f, 0.f};
        cur = nxt; cA = nA; cB = nB; ++ui;
        if (wr == 1) PG8_BAR;
    }
    PG8_WAIT_V(0);
    PG8_BAR;
#undef PG8_SA
#undef PG8_SB
#undef PG8_STAGE
#undef PG8_LDA
#undef PG8_LDB
#undef PG8_MMA
#undef PG8_WAIT_V
#undef PG8_WAIT_L
#undef PG8_BAR
#undef PG8_SCHED
}
}
constexpr int LDS_BYTES = 147456;
#if 0
template <class Job> __global__ void __launch_bounds__(512, 2) mgemm_kernel(Params P, int layer) {
    extern __shared__ __attribute__((aligned(16))) unsigned char lds[];
    const Ctx c(P, layer); const Job J(c);
    pg8::gemm_phase<Job>((PG8_LAS unsigned char*)lds, J, (int)blockIdx.x, (int)gridDim.x);
}
#endif

__device__ __forceinline__ void phase_conv(const Ctx& c, int vb, int nb) {
    const int tid = tid_opaque();
    for (size_t i = (size_t)vb * blockDim.x + tid; i < (size_t)T * D / 4; i += (size_t)nb * blockDim.x) {
        const int t = (int)((4 * i) / D), ch = (int)((4 * i) % D), s = t % SEQ;
        f32x4 acc = *(const f32x4*)(c.conv_b() + ch);
#pragma unroll
        for (int w = 0; w < 4; ++w) { const int ss = s - 3 + w; if (ss < 0) continue;
            const u32x2 v = *(const u32x2*)(c.XR() + (size_t)(t - 3 + w) * D + ch); const f32x4 cw = *(const f32x4*)(c.conv_w() + w * D + ch);
            acc[0] += cw[0] * __uint_as_float(v.x << 16); acc[1] += cw[1] * __uint_as_float(v.x & 0xffff0000u);
            acc[2] += cw[2] * __uint_as_float(v.y << 16); acc[3] += cw[3] * __uint_as_float(v.y & 0xffff0000u); }
        u32x2 o; o.x = pk2(acc[0], acc[1]); o.y = pk2(acc[2], acc[3]); *(u32x2*)(c.XC() + (size_t)t * D + ch) = o;
    }
}
__device__ __forceinline__ void phase_attn_simple(const Ctx& c, int vb, int nb) {
    const int tid = tid_opaque();
    for (int i = vb * blockDim.x + tid; i < 3 * T * 8; i += nb * blockDim.x) {
        const int h = i & 7, sr = (i >> 3) % T, g = i / (8 * T);
        const int d = dil_of(g), L = SEQ / d, l = sr % L;
        const bf16_t* Q = c.QKV() + (size_t)(g * 3 + 0) * T * 512; const bf16_t* Kp = c.QKV() + (size_t)(g * 3 + 1) * T * 512; const bf16_t* Vp = c.QKV() + (size_t)(g * 3 + 2) * T * 512;
        float q[64], o[64];
        for (int j = 0; j < 64; ++j) { q[j] = bf2f(Q[(size_t)sr * 512 + h * 64 + j]); o[j] = 0.f; }
        float m = -INFINITY, sum = 0.f;
        const int lo = l - 128 < 0 ? 0 : l - 128;
        for (int lk = lo; lk <= l; ++lk) { const size_t kr = (size_t)(sr - l + lk) * 512 + h * 64;
            float s = 0.f; for (int j = 0; j < 64; ++j) s += q[j] * bf2f(Kp[kr + j]);
            const float mn = fmaxf(m, s), f = __expf(m - mn), pz = __expf(s - mn);
            sum = sum * f + pz; for (int j = 0; j < 64; ++j) o[j] = o[j] * f + pz * bf2f(Vp[kr + j]); m = mn; }
        const int tok = token_of_split(g, sr); const float inv = 1.f / sum;
        bf16_t* op = c.OG() + (size_t)g * T * 512 + (size_t)tok * 512 + h * 64;
        for (int j = 0; j < 64; j += 2) *(unsigned*)(op + j) = pk2(o[j] * inv, o[j + 1] * inv);
        c.LSE()[((size_t)g * T + tok) * 8 + h] = m + __logf(sum);
    }
}
__device__ __forceinline__ void phase_scan1(const Ctx& c, int vb, int nb) {
    const int tid = tid_opaque();
    for (int u = vb; u < NB * 64 * 2; u += nb) {
        const int half = u & 1, seg = (u >> 1) & 63, b = u >> 7; const int ch = half * 512 + tid;
        const size_t base = ((size_t)b * SEQ + seg * 64) * D + ch; float P = 1.f, h = 0.f;
#pragma unroll 8
        for (int s = 0; s < 64; ++s) { const float a = c.AA()[base + (size_t)s * D], bx = c.BX()[base + (size_t)s * D]; h = a * h + bx; P *= a; c.AA()[base + (size_t)s * D] = P; c.BX()[base + (size_t)s * D] = h; }
        float* sg = c.SEGS() + (((size_t)b * 64 + seg) * D + ch) * 2; sg[0] = P; sg[1] = h;
    }
}
__device__ __forceinline__ void phase_attn_mix(const Ctx& c, int vb, int nb) {
    const int tid = tid_opaque();
    for (size_t i = (size_t)vb * blockDim.x + tid; i < (size_t)T * 512 / 4; i += (size_t)nb * blockDim.x) {
        const int t = (int)((4 * i) / 512), col = (int)((4 * i) % 512), h = col >> 6;
        const float l0 = c.LSE()[((size_t)0 * T + t) * 8 + h], l1 = c.LSE()[((size_t)1 * T + t) * 8 + h], l2 = c.LSE()[((size_t)2 * T + t) * 8 + h];
        const float m = fmaxf(l0, fmaxf(l1, l2)); float w0 = __expf(l0 - m), w1 = __expf(l1 - m), w2 = __expf(l2 - m); const float inv = 1.f / (w0 + w1 + w2); w0 *= inv; w1 *= inv; w2 *= inv;
        const u32x2 a = *(const u32x2*)(c.OG() + (size_t)0 * T * 512 + (size_t)t * 512 + col), b = *(const u32x2*)(c.OG() + (size_t)1 * T * 512 + (size_t)t * 512 + col), d = *(const u32x2*)(c.OG() + (size_t)2 * T * 512 + (size_t)t * 512 + col);
        f32x4 o;
        o[0] = w0 * __uint_as_float(a.x << 16) + w1 * __uint_as_float(b.x << 16) + w2 * __uint_as_float(d.x << 16);
        o[1] = w0 * __uint_as_float(a.x & 0xffff0000u) + w1 * __uint_as_float(b.x & 0xffff0000u) + w2 * __uint_as_float(d.x & 0xffff0000u);
        o[2] = w0 * __uint_as_float(a.y << 16) + w1 * __uint_as_float(b.y << 16) + w2 * __uint_as_float(d.y << 16);
        o[3] = w0 * __uint_as_float(a.y & 0xffff0000u) + w1 * __uint_as_float(b.y & 0xffff0000u) + w2 * __uint_as_float(d.y & 0xffff0000u);
        u32x2 r; r.x = pk2(o[0], o[1]); r.y = pk2(o[2], o[3]); *(u32x2*)(c.ACAT() + (size_t)t * KC + 1024 + col) = r;
    }
}
__device__ __forceinline__ void phase_scan2(const Ctx& c, int vb, int nb) {
    const int tid = tid_opaque();
    for (int u = vb; u < NB * 64 * 2; u += nb) {
        const int half = u & 1, seg = (u >> 1) & 63, b = u >> 7; const int ch = half * 512 + tid;
        float carry = 0.f;
        for (int s = 0; s < seg; ++s) { const float* sg = c.SEGS() + (((size_t)b * 64 + s) * D + ch) * 2; carry = sg[0] * carry + sg[1]; }
        const size_t t0 = (size_t)b * SEQ + seg * 64;
#pragma unroll 8
        for (int s = 0; s < 64; ++s) { const size_t o = (t0 + s) * D + ch; const float h = c.BX()[o] + c.AA()[o] * carry;
            c.ACAT()[(t0 + s) * KC + ch] = (bf16_t)f2bf(bf2f(c.GYR()[o]) * h); }
    }
}
__device__ __forceinline__ void ln_row(f32x4 (&v)[4], const float* g, const float* b, int lane) {
    float s = 0.f;
#pragma unroll
    for (int j = 0; j < 4; ++j) s += (v[j][0] + v[j][1]) + (v[j][2] + v[j][3]);
    const float mean = wave_sum(s) * (1.f / D); float s2 = 0.f;
#pragma unroll
    for (int j = 0; j < 4; ++j) { v[j] = v[j] - mean; s2 += (v[j][0] * v[j][0] + v[j][1] * v[j][1]) + (v[j][2] * v[j][2] + v[j][3] * v[j][3]); }
    const float rstd = 1.f / sqrtf(wave_sum(s2) * (1.f / D) + LN_EPS);
#pragma unroll
    for (int j = 0; j < 4; ++j) { const f32x4 gg = *(const f32x4*)(g + 4 * lane + 256 * j), bb = *(const f32x4*)(b + 4 * lane + 256 * j); v[j] = v[j] * rstd * gg + bb; }
}
__device__ __forceinline__ void phase_ln1_router(const Ctx& c, float* scr, int vb, int nb) {
    const int tid = tid_opaque();
    const int lane = tid & 63, wave = tid >> 6, nwv = blockDim.x >> 6;
    for (int t = vb * nwv + wave; t < T; t += nb * nwv) {
        f32x4 v[4];
#pragma unroll
        for (int j = 0; j < 4; ++j) v[j] = *(const f32x4*)(c.V() + (size_t)t * D + 4 * lane + 256 * j);
        ln_row(v, c.ln1g(), c.ln1b(), lane);
#pragma unroll
        for (int j = 0; j < 4; ++j) *(f32x4*)(c.x1() + (size_t)t * D + 4 * lane + 256 * j) = v[j];
        float* rowl = scr + wave * D;
#pragma unroll
        for (int j = 0; j < 4; ++j) *(f32x4*)(rowl + 4 * lane + 256 * j) = v[j];
        float lg[32];
#pragma unroll
        for (int e = 0; e < 32; ++e) lg[e] = 0.f;
        const f32x4* wr = (const f32x4*)(c.w_router() + (size_t)lane * NE);
#pragma unroll 2
        for (int kk = 0; kk < 16; ++kk) { const float xv = rowl[kk * 64 + lane];
#pragma unroll
            for (int e4 = 0; e4 < 8; ++e4) { const f32x4 w = wr[e4]; lg[4 * e4] += xv * w[0]; lg[4 * e4 + 1] += xv * w[1]; lg[4 * e4 + 2] += xv * w[2]; lg[4 * e4 + 3] += xv * w[3]; }
            wr += 64 * NE / 4; }
#pragma unroll
        for (int e = 0; e < 32; ++e) lg[e] = wave_sum(lg[e]) + c.b_router()[e];
        int te[4]; float tv[4]; unsigned used = 0u;
#pragma unroll
        for (int k = 0; k < 4; ++k) { float best = -INFINITY; int bi = 0;
#pragma unroll
            for (int e = 0; e < 32; ++e) { const bool ok = !((used >> e) & 1u) && lg[e] > best; best = ok ? lg[e] : best; bi = ok ? e : bi; }
            te[k] = bi; tv[k] = best; used |= 1u << bi; }
        const float e1 = __expf(tv[1] - tv[0]), e2 = __expf(tv[2] - tv[0]), e3 = __expf(tv[3] - tv[0]); const float inv = 1.f / (1.f + e1 + e2 + e3);
        if (lane < 4) { const float gk = (lane == 0 ? 1.f : lane == 1 ? e1 : lane == 2 ? e2 : e3) * inv; const int ek = lane == 0 ? te[0] : lane == 1 ? te[1] : lane == 2 ? te[2] : te[3];
            c.TOPE()[t * 4 + lane] = ek; c.TOPG()[t * 4 + lane] = gk; atomicAdd(&c.CNT()[ek], 1u); }
    }
}
__device__ __forceinline__ void phase_scatter(const Ctx& c, int vb, int nb) {
    const int tid = tid_opaque();
    const int lane = tid & 63, wave = tid >> 6, nwv = blockDim.x >> 6;
    for (int t = vb * nwv + wave; t < T; t += nb * nwv) {
        int slot = 0;
        if (lane < 4) { const int e = c.TOPE()[t * 4 + lane]; int base = 0; for (int i = 0; i < e; ++i) base += (int)((c.CNT()[i] + 255u) & ~255u);
            slot = base + (int)atomicAdd(&c.CUR()[e], 1u); c.SLOT()[t * 4 + lane] = slot; }
        u32x2 o[4];
#pragma unroll
        for (int j = 0; j < 4; ++j) { const f32x4 v = *(const f32x4*)(c.x1() + (size_t)t * D + 4 * lane + 256 * j); o[j].x = pk2(v[0], v[1]); o[j].y = pk2(v[2], v[3]); }
#pragma unroll
        for (int k = 0; k < 4; ++k) { const int sl = __shfl(slot, k);
#pragma unroll
            for (int j = 0; j < 4; ++j) *(u32x2*)(c.XG() + (size_t)sl * D + 4 * lane + 256 * j) = o[j]; }
    }
}
__device__ __forceinline__ void phase_combine_ln2(const Ctx& c, int vb, int nb) {
    const int tid = tid_opaque();
    const int lane = tid & 63, wave = tid >> 6, nwv = blockDim.x >> 6;
    for (int t = vb * nwv + wave; t < T; t += nb * nwv) {
        f32x4 v[4];
#pragma unroll
        for (int j = 0; j < 4; ++j) v[j] = *(const f32x4*)(c.x1() + (size_t)t * D + 4 * lane + 256 * j) * ALPHA;
#pragma unroll
        for (int k = 0; k < 4; ++k) { const int sl = c.SLOT()[t * 4 + k]; const float gk = c.TOPG()[t * 4 + k];
#pragma unroll
            for (int j = 0; j < 4; ++j) { const u32x2 y = *(const u32x2*)(c.YB() + (size_t)sl * D + 4 * lane + 256 * j);
                v[j][0] += gk * __uint_as_float(y.x << 16); v[j][1] += gk * __uint_as_float(y.x & 0xffff0000u); v[j][2] += gk * __uint_as_float(y.y << 16); v[j][3] += gk * __uint_as_float(y.y & 0xffff0000u); } }
        ln_row(v, c.ln2g(), c.ln2b(), lane);
#pragma unroll
        for (int j = 0; j < 4; ++j) { *(f32x4*)(c.x2() + (size_t)t * D + 4 * lane + 256 * j) = v[j]; u32x2 o; o.x = pk2(v[j][0], v[j][1]); o.y = pk2(v[j][2], v[j][3]);
            *(u32x2*)(c.ACAT2() + (size_t)t * KP + 256 + 4 * lane + 256 * j) = o; }
    }
}
__device__ __forceinline__ void phase_ln3(const Ctx& c, int vb, int nb) {
    const int tid = tid_opaque();
    const int lane = tid & 63, wave = tid >> 6, nwv = blockDim.x >> 6;
    for (int t = vb * nwv + wave; t < T; t += nb * nwv) {
        f32x4 v[4];
#pragma unroll
        for (int j = 0; j < 4; ++j) v[j] = *(const f32x4*)(c.V() + (size_t)t * D + 4 * lane + 256 * j);
        ln_row(v, c.ln3g(), c.ln3b(), lane);
#pragma unroll
        for (int j = 0; j < 4; ++j) { *(f32x4*)(c.x3() + (size_t)t * D + 4 * lane + 256 * j) = v[j]; u32x2 o; o.x = pk2(v[j][0], v[j][1]); o.y = pk2(v[j][2], v[j][3]);
            *(u32x2*)(c.XBF() + (size_t)t * D + 4 * lane + 256 * j) = o; }
    }
}


#define LAS __attribute__((address_space(3)))
#define XB_TMO      128
#define XB_XCNT(j)  (256  + 64 * (j))
#define XB_XSUB(j)  (1280 + 64 * (j))
#define XB_XGEN(j)  (2304 + 64 * (j))
#define XB_TOP      3328
#define XB_TOPGEN   3392
#define XCD_BAR_WORDS 3456
#define XB_SPIN_CAP (1u << 18)
__device__ __forceinline__ unsigned xb_ld(unsigned* p)              { return __hip_atomic_load(p, __ATOMIC_RELAXED, __HIP_MEMORY_SCOPE_AGENT); }
__device__ __forceinline__ unsigned xb_add(unsigned* p, unsigned v) { return __hip_atomic_fetch_add(p, v, __ATOMIC_RELAXED, __HIP_MEMORY_SCOPE_AGENT); }
__device__ __forceinline__ unsigned xb_xcc_id() { return (unsigned)__builtin_amdgcn_s_getreg((3 << 11) | 20) & 0xFu; }
#define XB_SPIN(cond, bar) do { unsigned _sp = 0; while (cond) { __builtin_amdgcn_s_sleep(1); \
    if ((++_sp & 255u) == 0u) { if (xb_ld(&(bar)[XB_TMO])) break; if (_sp > XB_SPIN_CAP) { atomicAdd(&(bar)[XB_TMO], 1u); break; } } } } while (0)
struct XcdBarrier { unsigned* bar; unsigned x; volatile LAS unsigned* st; };
__device__ __forceinline__ XcdBarrier xcd_barrier_post(unsigned* bar, volatile LAS unsigned* st) {
    XcdBarrier b; b.bar = bar; b.x = xb_xcc_id(); b.st = st;
    if (threadIdx.x == 0) (void)xb_add(&bar[XB_XCNT(b.x)], 1u);
    return b;
}
__device__ __forceinline__ void xcd_barrier_complete(unsigned* bar, unsigned x, unsigned& nloc, unsigned& nx) {
    const unsigned G = gridDim.x * gridDim.y * gridDim.z;
    unsigned sum, cnt, mine, sp = 0u;
    for (;;) {
        sum = 0u; cnt = 0u; mine = 0u;
#pragma unroll
        for (unsigned j = 0; j < 16; ++j) { const unsigned c = xb_ld(&bar[XB_XCNT(j)]); sum += c; cnt += (c > 0u) ? 1u : 0u; mine = (j == x) ? c : mine; }
        if (sum == G) break;
        __builtin_amdgcn_s_sleep(1);
        if ((++sp & 255u) == 0u) { if (xb_ld(&bar[XB_TMO])) break; if (sp > XB_SPIN_CAP) { atomicAdd(&bar[XB_TMO], 1u); break; } }
    }
    nloc = mine > 0u ? mine : 1u; nx = cnt > 0u ? cnt : 1u;
}
__device__ __forceinline__ void xcd_barrier(const XcdBarrier& b) {
    asm volatile("s_waitcnt vmcnt(0)" ::: "memory");
    __syncthreads();
    if (threadIdx.x == 0) {
        unsigned* bar = b.bar; asm volatile("" : "+s"(bar));
        __builtin_amdgcn_s_waitcnt(0);
        unsigned nloc = b.st[0], nx = b.st[1];
        if (nloc == 0u) { xcd_barrier_complete(bar, b.x, nloc, nx); b.st[0] = nloc; b.st[1] = nx; }
        const unsigned old = xb_add(&bar[XB_XSUB(b.x)], 1u);
        const unsigned gen = old / nloc;
        if (old + 1u == (gen + 1u) * nloc) {
            __builtin_amdgcn_fence(__ATOMIC_RELEASE, "agent");
            asm volatile("s_waitcnt vmcnt(0)" ::: "memory");
            const unsigned og = xb_add(&bar[XB_TOP], 1u);
            const unsigned tg = og / nx;
            if (og + 1u == (tg + 1u) * nx) xb_add(&bar[XB_TOPGEN], 1u);
            else XB_SPIN(xb_ld(&bar[XB_TOPGEN]) == tg, bar);
            __builtin_amdgcn_fence(__ATOMIC_ACQUIRE, "agent");
            xb_add(&bar[XB_XGEN(b.x)], 1u);
            asm volatile("s_waitcnt vmcnt(0)" ::: "memory");
        } else {
            XB_SPIN(xb_ld(&bar[XB_XGEN(b.x)]) == gen, bar);
            __builtin_amdgcn_fence(__ATOMIC_ACQUIRE, "agent");
            asm volatile("s_waitcnt vmcnt(0)" ::: "memory");
        }
    }
    __syncthreads();
}
constexpr int CW_BAR = 4096;
constexpr int RING_BYTES = 131072, LDSCTL_OFF = RING_BYTES, MISC_OFF = LDSCTL_OFF + 320;

__global__ void __launch_bounds__(512, 2) mega_kernel(Params P) {
    extern __shared__ __attribute__((aligned(16))) unsigned char lds[];
    LAS unsigned char* L = (LAS unsigned char*)lds;
    for (int u = threadIdx.x; u < (LDS_BYTES - LDSCTL_OFF) / 4; u += 512) ((LAS unsigned*)(L + LDSCTL_OFF))[u] = 0u;
    __syncthreads();
    const XcdBarrier bar = xcd_barrier_post((unsigned*)(P.ws + WS_CTL) + CW_BAR, (volatile LAS unsigned*)(L + MISC_OFF) + 8);
    const int vb = blockIdx.x, nb = gridDim.x;
#define GRID_BAR() xcd_barrier(bar)
#define LAYER_BODY(l) do { \
        { const Ctx c(l); phase_convert(c, (float*)lds, vb, nb); } GRID_BAR(); \
        { const Ctx c(l); const JobInproj J(c); pg8::gemm_phase<JobInproj>(L, J, vb, nb); } GRID_BAR(); \
        { const Ctx c(l); phase_conv(c, vb, nb); } { const Ctx c(l); phase_attn_simple(c, vb, nb); } GRID_BAR(); \
        { const Ctx c(l); const JobGate J(c); pg8::gemm_phase<JobGate>(L, J, vb, nb); } GRID_BAR(); \
        { const Ctx c(l); phase_scan1(c, vb, nb); } { const Ctx c(l); phase_attn_mix(c, vb, nb); } GRID_BAR(); \
        { const Ctx c(l); phase_scan2(c, vb, nb); } GRID_BAR(); \
        { const Ctx c(l); const JobY J(c); pg8::gemm_phase<JobY>(L, J, vb, nb); } GRID_BAR(); \
        { const Ctx c(l); const JobOut J(c); pg8::gemm_phase<JobOut>(L, J, vb, nb); } GRID_BAR(); \
        { const Ctx c(l); phase_ln1_router(c, (float*)lds, vb, nb); } GRID_BAR(); \
        { const Ctx c(l); phase_scatter(c, vb, nb); } GRID_BAR(); \
        { const Ctx c(l); const JobMoeGU J(c); pg8::gemm_phase<JobMoeGU>(L, J, vb, nb); } GRID_BAR(); \
        { const Ctx c(l); const JobMoeD J(c); pg8::gemm_phase<JobMoeD>(L, J, vb, nb); } GRID_BAR(); \
        { const Ctx c(l); phase_combine_ln2(c, vb, nb); } GRID_BAR(); \
        { const Ctx c(l); const JobPle J(c); pg8::gemm_phase<JobPle>(L, J, vb, nb); } GRID_BAR(); \
        { const Ctx c(l); phase_ln3(c, vb, nb); } if (l == 0) GRID_BAR(); \
 \
    } while (0)
    LAYER_BODY(0);
    LAYER_BODY(1);
#undef LAYER_BODY
}

#if 0
template <int PH> __global__ void __launch_bounds__(512) ew_kernel(Params P, int layer) {
    __shared__ float scr[8 * 64 * 33];
    const Ctx c(P, layer); const int vb = blockIdx.x, nb = gridDim.x;
    if (PH == 0) phase_convert(c, scr, vb, nb);
    else if (PH == 1) phase_conv(c, vb, nb);
    else if (PH == 2) phase_attn_simple(c, vb, nb);
    else if (PH == 3) phase_scan1(c, vb, nb);
    else if (PH == 4) phase_attn_mix(c, vb, nb);
    else if (PH == 5) phase_scan2(c, vb, nb);
    else if (PH == 6) phase_ln1_router(c, (float*)lds, vb, nb);
    else if (PH == 7) phase_scatter(c, vb, nb);
    else if (PH == 8) phase_combine_ln2(c, vb, nb);
    else if (PH == 9) phase_ln3(c, vb, nb);
}

#endif
extern "C" void kernel_launch(void* const* d_in, const int* in_sizes, int n_in, void* d_out, int out_size, void* d_ws, size_t ws_size, hipStream_t stream) {
    static int grid = 0;
    if (grid == 0) {
        if (n_in != 30 || ws_size < WS_END) { fprintf(stderr, "kernel_launch: unexpected n_in %d or ws_size %zu\n", n_in, ws_size); grid = -1; return; }
        int dev = 0, cus = 0;
        if (hipGetDevice(&dev) != hipSuccess || hipDeviceGetAttribute(&cus, hipDeviceAttributeMultiprocessorCount, dev) != hipSuccess) { grid = -1; return; }
        if (hipFuncSetAttribute((const void*)mega_kernel, hipFuncAttributeMaxDynamicSharedMemorySize, LDS_BYTES) != hipSuccess) { fprintf(stderr, "kernel_launch: hipFuncSetAttribute failed\n"); grid = -1; return; }
        grid = cus;
    }
    if (grid < 0) return;
    Params P{}; for (int i = 0; i < 30; ++i) P.in[i] = (const float*)d_in[i]; P.out = (float*)d_out; P.ws = (unsigned char*)d_ws;
    (void)hipMemsetAsync((char*)d_ws + WS_CTL, 0, CTL_BYTES, stream);
    hipLaunchKernelGGL(mega_kernel, dim3(grid), dim3(512), LDS_BYTES, stream, P);
}
```

```cpp
#include <hip/hip_runtime.h>
#include <stdint.h>
#include <stdio.h>

typedef unsigned short bf16_t;
#define LAS __attribute__((address_space(3)))
typedef float f32x4 __attribute__((ext_vector_type(4)));
typedef unsigned u32x4 __attribute__((ext_vector_type(4)));
typedef unsigned u32x2 __attribute__((ext_vector_type(2)));

constexpr int NB = 4, SEQ = 4096, T = NB * SEQ, D = 1024, NIN = 8704, NE = 32, TOPK = 4, PLED = 256;
constexpr int NSLOT = T * TOPK + NE * 256;
constexpr float ALPHA = 1.41421356237309515f;
constexpr float LN_EPS = 1e-5f;
constexpr int KP = 1280;
constexpr int KC = 1536;

constexpr size_t MiB = 1u << 20;
constexpr size_t WS_CTL = 0, CTL_BYTES = 1 * MiB;
constexpr size_t WS_SEG = 1 * MiB, WS_ROUTE = 3 * MiB, WS_LSE = 4 * MiB;
constexpr size_t WS_WIN = 6 * MiB, WS_WG = 23 * MiB, WS_WCAT = 24 * MiB, WS_WOUT = 27 * MiB, WS_WPLE = 29 * MiB, WS_WGU = 32 * MiB, WS_WD = 160 * MiB;
constexpr size_t WS_XA = 224 * MiB, WS_V = 288 * MiB, WS_XBF = 352 * MiB, WS_ACAT2 = 384 * MiB, WS_R = 424 * MiB, WS_END = 856 * MiB;
constexpr size_t R_XR = 0, R_GYR = 32 * MiB, R_QKV = 64 * MiB, R_GR = 208 * MiB, R_GB = 240 * MiB, R_OG = 272 * MiB, R_ACAT = 320 * MiB, R_MERGED = 368 * MiB, R_XC = 400 * MiB;
constexpr size_t R_AA = 64 * MiB, R_BX = 128 * MiB;
constexpr size_t R_XG = 0, R_H = 144 * MiB, R_YB = 288 * MiB;
constexpr int CW_CNT = 1024, CW_CUR = 1024 + 64;

struct Params { const float* in[30]; float* out; unsigned char* ws; };

__device__ __forceinline__ float bf2f(bf16_t h) { return __uint_as_float((unsigned)h << 16); }
__device__ __forceinline__ unsigned f2bf(float f) { unsigned u = __float_as_uint(f); return (u + 0x7fffu + ((u >> 16) & 1u)) >> 16; }
__device__ __forceinline__ unsigned pk2(float lo, float hi) { return f2bf(lo) | (f2bf(hi) << 16); }
__device__ __forceinline__ float sigmoidf_(float x) { return __builtin_amdgcn_rcpf(1.f + __expf(-x)); }
__device__ __forceinline__ float gelu_tanh(float x) { const float u = 0.7978845608028654f * (x + 0.044715f * x * x * x); const float e = __expf(2.f * u); const float th = 1.f - 2.f / (e + 1.f); return 0.5f * x * (1.f + th); }
__device__ __forceinline__ float wave_sum(float v) {
#pragma unroll
    for (int o = 1; o < 64; o <<= 1) v += __shfl_xor(v, o);
    return v;
}

__device__ __forceinline__ int tid_opaque() { int t = threadIdx.x; asm volatile("" : "+v"(t)); return t; }
struct Ctx {
    typedef const __attribute__((address_space(4))) Params* KP;
    KP P; int layer;
    __device__ __forceinline__ explicit Ctx(int l) : layer(l) { KP k = (KP)__builtin_amdgcn_kernarg_segment_ptr(); asm volatile("" : "+s"(k)); P = k; }
#define WSP(T_, off) ((T_*)(P->ws + (off)))
    __device__ __forceinline__ float* XAbuf() const { return WSP(float, WS_XA); }
    __device__ __forceinline__ const float* xin() const { return layer == 0 ? P->in[0] : (const float*)XAbuf(); }
    __device__ __forceinline__ float* x1() const { return layer == 0 ? XAbuf() : P->out; }
    __device__ __forceinline__ float* x2() const { return layer == 0 ? P->out : XAbuf(); }
    __device__ __forceinline__ float* x3() const { return layer == 0 ? XAbuf() : P->out; }
    __device__ __forceinline__ float* V() const { return WSP(float, WS_V); }
    __device__ __forceinline__ const float* p() const { return P->in[1] + (size_t)layer * T * PLED; }
    __device__ __forceinline__ const float* w_in() const { return P->in[2] + (size_t)layer * D * NIN; }
    __device__ __forceinline__ const float* conv_w() const { return P->in[3] + layer * 4 * D; }
    __device__ __forceinline__ const float* conv_b() const { return P->in[4] + layer * D; }
    __device__ __forceinline__ const float* w_rg() const { return P->in[5] + (size_t)layer * 4 * 256 * 256; }
    __device__ __forceinline__ const float* b_rg() const { return P->in[6] + layer * D; }
    __device__ __forceinline__ const float* w_ig() const { return P->in[7] + (size_t)layer * 4 * 256 * 256; }
    __device__ __forceinline__ const float* b_ig() const { return P->in[8] + layer * D; }
    __device__ __forceinline__ const float* lam() const { return P->in[9] + layer * D; }
    __device__ __forceinline__ const float* w_rnn_out() const { return P->in[10] + (size_t)layer * D * D; }
    __device__ __forceinline__ const float* w_att_out() const { return P->in[11] + (size_t)layer * 512 * D; }
    __device__ __forceinline__ const float* w_out() const { return P->in[12] + (size_t)layer * D * D; }
    __device__ __forceinline__ const float* ln1g() const { return P->in[13] + layer * D; }
    __device__ __forceinline__ const float* ln1b() const { return P->in[14] + layer * D; }
    __device__ __forceinline__ const float* w_router() const { return P->in[15] + (size_t)layer * D * NE; }
    __device__ __forceinline__ const float* b_router() const { return P->in[16] + layer * NE; }
    __device__ __forceinline__ const float* w_gate() const { return P->in[17] + (size_t)layer * NE * D * D; }
    __device__ __forceinline__ const float* b_gate() const { return P->in[18] + (size_t)layer * NE * D; }
    __device__ __forceinline__ const float* w_up() const { return P->in[19] + (size_t)layer * NE * D * D; }
    __device__ __forceinline__ const float* b_up() const { return P->in[20] + (size_t)layer * NE * D; }
    __device__ __forceinline__ const float* w_down() const { return P->in[21] + (size_t)layer * NE * D * D; }
    __device__ __forceinline__ const float* b_down() const { return P->in[22] + (size_t)layer * NE * D; }
    __device__ __forceinline__ const float* ln2g() const { return P->in[23] + layer * D; }
    __device__ __forceinline__ const float* ln2b() const { return P->in[24] + layer * D; }
    __device__ __forceinline__ const float* w_ple() const { return P->in[25] + (size_t)layer * PLED * D; }
    __device__ __forceinline__ const float* w_pg() const { return P->in[26] + (size_t)layer * D * D; }
    __device__ __forceinline__ const float* b_pg() const { return P->in[27] + layer * D; }
    __device__ __forceinline__ const float* ln3g() const { return P->in[28] + layer * D; }
    __device__ __forceinline__ const float* ln3b() const { return P->in[29] + layer * D; }
    __device__ __forceinline__ bf16_t* WIN() const { return WSP(bf16_t, WS_WIN); }
    __device__ __forceinline__ bf16_t* WG() const { return WSP(bf16_t, WS_WG); }
    __device__ __forceinline__ bf16_t* WCAT() const { return WSP(bf16_t, WS_WCAT); }
    __device__ __forceinline__ bf16_t* WOUT() const { return WSP(bf16_t, WS_WOUT); }
    __device__ __forceinline__ bf16_t* WPLE() const { return WSP(bf16_t, WS_WPLE); }
    __device__ __forceinline__ bf16_t* WGU() const { return WSP(bf16_t, WS_WGU); }
    __device__ __forceinline__ bf16_t* WD() const { return WSP(bf16_t, WS_WD); }
    __device__ __forceinline__ bf16_t* XBF() const { return WSP(bf16_t, WS_XBF); }
    __device__ __forceinline__ bf16_t* ACAT2() const { return WSP(bf16_t, WS_ACAT2); }
    __device__ __forceinline__ bf16_t* XR() const { return WSP(bf16_t, WS_R + R_XR); }
    __device__ __forceinline__ bf16_t* GYR() const { return WSP(bf16_t, WS_R + R_GYR); }
    __device__ __forceinline__ bf16_t* QKV() const { return WSP(bf16_t, WS_R + R_QKV); }
    __device__ __forceinline__ bf16_t* GR() const { return WSP(bf16_t, WS_R + R_GR); }
    __device__ __forceinline__ bf16_t* GB() const { return WSP(bf16_t, WS_R + R_GB); }
    __device__ __forceinline__ bf16_t* OG() const { return WSP(bf16_t, WS_R + R_OG); }
    __device__ __forceinline__ bf16_t* ACAT() const { return WSP(bf16_t, WS_R + R_ACAT); }
    __device__ __forceinline__ bf16_t* MERGED() const { return WSP(bf16_t, WS_R + R_MERGED); }
    __device__ __forceinline__ bf16_t* XC() const { return WSP(bf16_t, WS_R + R_XC); }
    __device__ __forceinline__ bf16_t* XG() const { return WSP(bf16_t, WS_R + R_XG); }
    __device__ __forceinline__ bf16_t* H() const { return WSP(bf16_t, WS_R + R_H); }
    __device__ __forceinline__ bf16_t* YB() const { return WSP(bf16_t, WS_R + R_YB); }
    __device__ __forceinline__ float* AA() const { return WSP(float, WS_R + R_AA); }
    __device__ __forceinline__ float* BX() const { return WSP(float, WS_R + R_BX); }
    __device__ __forceinline__ float* SEGS() const { return WSP(float, WS_SEG); }
    __device__ __forceinline__ float* LSE() const { return WSP(float, WS_LSE); }
    __device__ __forceinline__ float* SP() const { return WSP(float, WS_ROUTE + 768 * 1024) + layer * D; }
    __device__ __forceinline__ int* TOPE() const { return WSP(int, WS_ROUTE); }
    __device__ __forceinline__ float* TOPG() const { return WSP(float, WS_ROUTE + 256 * 1024); }
    __device__ __forceinline__ int* SLOT() const { return WSP(int, WS_ROUTE + 512 * 1024); }
    __device__ __forceinline__ unsigned* CNT() const { return WSP(unsigned, WS_CTL) + CW_CNT + 128 * layer; }
    __device__ __forceinline__ unsigned* CUR() const { return WSP(unsigned, WS_CTL) + CW_CUR + 128 * layer; }
#undef WSP
};
__device__ __forceinline__ int dil_of(int g) { return 1 << (2 * g); }
__device__ __forceinline__ int split_row(int g, int tok) { const int d = dil_of(g), b = tok / SEQ, s = tok % SEQ; return (b * d + (s % d)) * (SEQ / d) + s / d; }
__device__ __forceinline__ int token_of_split(int g, int sr) { const int d = dil_of(g), L = SEQ / d, bd = sr / L, l = sr % L; return (bd / d) * SEQ + l * d + (bd % d); }

struct CvtJob { const float* W; int lds; int K, N; bf16_t* dst; int ldd; int mode, ty; };
__device__ __forceinline__ int cvt_items(const CvtJob& j) { return (j.K / 64) * (j.N / 32); }
__device__ __forceinline__ CvtJob cvt_job(const Ctx& c, int j) {
    CvtJob r;
    if (j == 0) { r = {c.w_in(), NIN, D, 6656, c.WIN(), D, 0, 0}; }
    else if (j == 1) { r = {c.w_in() + 6656, NIN, D, 1024, c.WIN() + (size_t)6656 * D, D, 1, 0}; }
    else if (j == 2) { r = {c.w_in() + 7680, NIN, D, 1024, c.WIN() + (size_t)6656 * D, D, 1, 1}; }
    else if (j < 11) { const int q = j - 3, nb = q >> 1, gt = q & 1; r = {(gt ? c.w_ig() : c.w_rg()) + (size_t)nb * 65536, 256, 256, 256, c.WG() + (size_t)nb * 512 * 256, 256, 1, gt}; }
    else if (j == 11) { r = {c.w_rnn_out(), D, D, D, c.WCAT(), KC, 0, 0}; }
    else if (j == 12) { r = {c.w_att_out(), D, 512, D, c.WCAT() + 1024, KC, 0, 0}; }
    else if (j == 13) { r = {c.w_out(), D, D, D, c.WOUT(), D, 0, 0}; }
    else if (j == 14) { r = {c.w_ple(), D, PLED, D, c.WPLE(), KP, 0, 0}; }
    else if (j == 15) { r = {c.w_pg(), D, D, D, c.WPLE() + 256, KP, 0, 0}; }
    else { const int q = j - 16, e = q / 3, w = q % 3;
        if (w == 0) r = {c.w_gate() + (size_t)e * D * D, D, D, D, c.WGU() + (size_t)e * 2048 * D, D, 1, 0};
        else if (w == 1) r = {c.w_up() + (size_t)e * D * D, D, D, D, c.WGU() + (size_t)e * 2048 * D, D, 1, 1};
        else r = {c.w_down() + (size_t)e * D * D, D, D, D, c.WD() + (size_t)e * D * D, D, 0, 0}; }
    return r;
}
constexpr int CVT_NJOBS = 16 + 3 * NE;
__device__ __forceinline__ void cvt_item(const CvtJob& J, int item, float* scr, int lane) {
    const int nblk = J.N / 32, kb = item / nblk, nb = item % nblk, k0 = 64 * kb, n0 = 32 * nb;
#pragma unroll 8
    for (int i = 0; i < 32; ++i) { const int kk = 2 * i + (lane >> 5); scr[kk * 33 + (lane & 31)] = J.W[(size_t)(k0 + kk) * J.lds + n0 + (lane & 31)]; }
    __builtin_amdgcn_s_waitcnt(0xc07f); asm volatile("" ::: "memory");
    const int cch = lane & 7;
    const int r0 = J.mode ? ((n0 >> 7) * 256 + J.ty * 128 + (n0 & 127)) : n0;
#pragma unroll
    for (int j = 0; j < 4; ++j) { const int n = (lane >> 3) + 8 * j; const float* s = scr + (8 * cch) * 33 + n;
        u32x4 o; o.x = pk2(s[0 * 33], s[1 * 33]); o.y = pk2(s[2 * 33], s[3 * 33]); o.z = pk2(s[4 * 33], s[5 * 33]); o.w = pk2(s[6 * 33], s[7 * 33]);
        *(u32x4*)(J.dst + (size_t)(r0 + n) * J.ldd + k0 + 8 * cch) = o; }
    __builtin_amdgcn_s_waitcnt(0xc07f); asm volatile("" ::: "memory");
}
__device__ __forceinline__ void phase_convert(const Ctx& c, float* scr_all, int vb, int nb) {
    const int tid = tid_opaque();
    const int lane = tid & 63, wave = tid >> 6, nwv = blockDim.x >> 6;
    float* scr = scr_all + wave * (64 * 33);
    const int gw = vb * nwv + wave, NGW = nb * nwv;
    int base = 0;
    for (int j = 0; j < CVT_NJOBS; ++j) {
        const CvtJob J = cvt_job(c, j); const int ni = cvt_items(J);
        int first = gw - (base % NGW); if (first < 0) first += NGW;
        for (int it = first; it < ni; it += NGW) cvt_item(J, it, scr, lane);
        base += ni;
    }
    if (vb == 0) for (int i = tid; i < D; i += blockDim.x) c.SP()[i] = log1pf(__expf(-c.lam()[i]));
    if (c.layer == 0) {
        for (size_t i = (size_t)(vb * blockDim.x + tid); i < (size_t)T * D / 4; i += (size_t)nb * blockDim.x) {
            const f32x4 v = *(const f32x4*)(c.xin() + 4 * i); u32x2 o; o.x = pk2(v.x, v.y); o.y = pk2(v.z, v.w); *(u32x2*)(c.XBF() + 4 * i) = o; }
    }
    for (size_t i = (size_t)(vb * blockDim.x + tid); i < (size_t)T * PLED / 4; i += (size_t)nb * blockDim.x) {
        const f32x4 v = *(const f32x4*)(c.p() + 4 * i); u32x2 o; o.x = pk2(v.x, v.y); o.y = pk2(v.z, v.w);
        const size_t row = (4 * i) / PLED, col = (4 * i) % PLED; *(u32x2*)(c.ACAT2() + row * KP + col) = o; }
}

struct Unit { int pm, pn, e; };

struct JobInproj {
    static constexpr int K = 1024, KMID = 0, MAXU = 64 * 34, LDA = D, LDB = D;
    Ctx c; __device__ JobInproj(const Ctx& c_) : c(c_) {}
    __device__ bool unit(int idx, Unit& u, const bf16_t*& A, const bf16_t*& Bt) const {
        if (idx >= MAXU) return false; u.pm = idx % 64; u.pn = idx / 64; u.e = 0;
        A = c.XBF() + (size_t)u.pm * 256 * D; Bt = c.WIN() + (size_t)u.pn * 256 * D; return true; }
    __device__ void mid(const Unit&, int, int, f32x4&, f32x4&) const {}
    __device__ void epi(const Unit& u, int row, int col, f32x4 v0, f32x4 v1) const {
        if (col < 1024) { st4(c.XR() + (size_t)row * D + col, v0); st4(c.XR() + (size_t)row * D + col + 128, v1); }
        else if (col < 2048) { const int cc = col - 1024; f32x4 a, b;
            for (int j = 0; j < 4; ++j) { a[j] = gelu_tanh(v0[j]); b[j] = gelu_tanh(v1[j]); }
            st4(c.GYR() + (size_t)row * D + cc, a); st4(c.GYR() + (size_t)row * D + cc + 128, b); }
        else if (col < 6656) { const int q = col - 2048, which = q / 1536, g = (q % 1536) / 512, cc = q % 512;
            const float sc = which == 0 ? 0.125f : 1.f; bf16_t* dst = c.QKV() + (size_t)(g * 3 + which) * T * 512 + (size_t)split_row(g, row) * 512 + cc;
            st4(dst, v0 * sc); st4(dst + 128, v1 * sc); }
        else { const int cc = (col - 6656) / 256 * 128 + (col - 6656) % 256;
            f32x4 r, s; for (int j = 0; j < 4; ++j) { const float sa = sigmoidf_(v0[j]), sb = sigmoidf_(v1[j]); r[j] = sa / sb; s[j] = sb; }
            st4(c.GR() + (size_t)row * D + cc, r); st4(c.GB() + (size_t)row * D + cc, s); }
    }
    static __device__ __forceinline__ void st4(bf16_t* p, f32x4 v) { u32x2 o; o.x = pk2(v[0], v[1]); o.y = pk2(v[2], v[3]); *(u32x2*)p = o; }
};
struct JobGate {
    static constexpr int K = 256, KMID = 0, MAXU = 64 * 8, LDA = D, LDB = 256;
    Ctx c; __device__ JobGate(const Ctx& c_) : c(c_) {}
    __device__ bool unit(int idx, Unit& u, const bf16_t*& A, const bf16_t*& Bt) const {
        if (idx >= MAXU) return false; u.pm = idx % 64; u.pn = idx / 64; u.e = 0;
        A = c.XC() + (size_t)u.pm * 256 * D + (u.pn >> 1) * 256; Bt = c.WG() + (size_t)u.pn * 256 * 256; return true; }
    __device__ void mid(const Unit&, int, int, f32x4&, f32x4&) const {}
    __device__ void epi(const Unit& u, int row, int col, f32x4 v0, f32x4 v1) const {
        const int ch = (col >> 8) * 128 + (col & 255);
        f32x4 a, bx;
        for (int j = 0; j < 4; ++j) { const int cc = ch + j;
            const float r = sigmoidf_(v0[j] + c.b_rg()[cc]), ig = sigmoidf_(v1[j] + c.b_ig()[cc]);
            const float la = -8.f * r * c.SP()[cc]; const float av = __expf(la);
            const float xc = bf2f(c.XC()[(size_t)row * D + cc]);
            const float x2_ = 2.f * la; const float om = -x2_ * (1.f + x2_ * (0.5f + x2_ * (0.16666667f + x2_ * (0.041666668f + x2_ * 0.0083333338f))));
            a[j] = av; bx[j] = sqrtf(om) * (ig * xc); }
        *(f32x4*)(c.AA() + (size_t)row * D + ch) = a; *(f32x4*)(c.BX() + (size_t)row * D + ch) = bx;
    }
};
struct JobY {
    static constexpr int K = KC, KMID = 1024, MAXU = 64 * 4, LDA = KC, LDB = KC;
    Ctx c; __device__ JobY(const Ctx& c_) : c(c_) {}
    __device__ bool unit(int idx, Unit& u, const bf16_t*& A, const bf16_t*& Bt) const {
        if (idx >= MAXU) return false; u.pm = idx % 64; u.pn = idx / 64; u.e = 0;
        A = c.ACAT() + (size_t)u.pm * 256 * KC; Bt = c.WCAT() + (size_t)u.pn * 256 * KC; return true; }
    __device__ void mid(const Unit&, int row, int col, f32x4& v0, f32x4& v1) const {
        for (int j = 0; j < 4; ++j) { v0[j] *= bf2f(c.GR()[(size_t)row * D + col + j]); v1[j] *= bf2f(c.GR()[(size_t)row * D + col + 128 + j]); } }
    __device__ void epi(const Unit&, int row, int col, f32x4 v0, f32x4 v1) const {
        for (int j = 0; j < 4; ++j) { v0[j] *= bf2f(c.GB()[(size_t)row * D + col + j]); v1[j] *= bf2f(c.GB()[(size_t)row * D + col + 128 + j]); }
        JobInproj::st4(c.MERGED() + (size_t)row * D + col, v0); JobInproj::st4(c.MERGED() + (size_t)row * D + col + 128, v1); }
};
struct JobOut {
    static constexpr int K = 1024, KMID = 0, MAXU = 64 * 4, LDA = D, LDB = D;
    Ctx c; __device__ JobOut(const Ctx& c_) : c(c_) {}
    __device__ bool unit(int idx, Unit& u, const bf16_t*& A, const bf16_t*& Bt) const {
        if (idx >= MAXU) return false; u.pm = idx % 64; u.pn = idx / 64; u.e = 0;
        A = c.MERGED() + (size_t)u.pm * 256 * D; Bt = c.WOUT() + (size_t)u.pn * 256 * D; return true; }
    __device__ void mid(const Unit&, int, int, f32x4&, f32x4&) const {}
    __device__ void epi(const Unit&, int row, int col, f32x4 v0, f32x4 v1) const {
        const f32x4 x0 = *(const f32x4*)(c.xin() + (size_t)row * D + col), x1 = *(const f32x4*)(c.xin() + (size_t)row * D + col + 128);
        *(f32x4*)(c.V() + (size_t)row * D + col) = x0 * ALPHA + v0; *(f32x4*)(c.V() + (size_t)row * D + col + 128) = x1 * ALPHA + v1; }
};
__device__ __forceinline__ bool moe_tile(const unsigned* CNT, int mt, int& e) {
    int acc = 0;
    for (int i = 0; i < NE; ++i) { const int nt = (int)((CNT[i] + 255u) >> 8); if (mt < acc + nt) { e = i; return true; } acc += nt; }
    return false;
}
struct JobMoeGU {
    static constexpr int K = 1024, KMID = 0, MAXU = 288 * 8, LDA = D, LDB = D;
    Ctx c; __device__ JobMoeGU(const Ctx& c_) : c(c_) {}
    __device__ bool unit(int idx, Unit& u, const bf16_t*& A, const bf16_t*& Bt) const {
        u.pm = idx / 8; u.pn = idx % 8; if (u.pm >= 288 || !moe_tile(c.CNT(), u.pm, u.e)) return false;
        A = c.XG() + (size_t)u.pm * 256 * D; Bt = c.WGU() + (size_t)u.e * 2048 * D + (size_t)u.pn * 256 * D; return true; }
    __device__ void mid(const Unit&, int, int, f32x4&, f32x4&) const {}
    __device__ void epi(const Unit& u, int row, int col, f32x4 v0, f32x4 v1) const {
        const int ch = (col >> 8) * 128 + (col & 255); f32x4 h;
        for (int j = 0; j < 4; ++j) { float g = v0[j] + c.b_gate()[u.e * D + ch + j], up = v1[j] + c.b_up()[u.e * D + ch + j];
            g = fminf(g, 7.f); up = fminf(fmaxf(up, -7.f), 7.f); h[j] = (up + 1.f) * (g * sigmoidf_(1.702f * g)); }
        JobInproj::st4(c.H() + (size_t)row * D + ch, h); }
};
struct JobMoeD {
    static constexpr int K = 1024, KMID = 0, MAXU = 288 * 4, LDA = D, LDB = D;
    Ctx c; __device__ JobMoeD(const Ctx& c_) : c(c_) {}
    __device__ bool unit(int idx, Unit& u, const bf16_t*& A, const bf16_t*& Bt) const {
        u.pm = idx / 4; u.pn = idx % 4; if (u.pm >= 288 || !moe_tile(c.CNT(), u.pm, u.e)) return false;
        A = c.H() + (size_t)u.pm * 256 * D; Bt = c.WD() + (size_t)u.e * D * D + (size_t)u.pn * 256 * D; return true; }
    __device__ void mid(const Unit&, int, int, f32x4&, f32x4&) const {}
    __device__ void epi(const Unit& u, int row, int col, f32x4 v0, f32x4 v1) const {
        const f32x4 b0 = *(const f32x4*)(c.b_down() + u.e * D + col), b1 = *(const f32x4*)(c.b_down() + u.e * D + col + 128);
        JobInproj::st4(c.YB() + (size_t)row * D + col, v0 + b0); JobInproj::st4(c.YB() + (size_t)row * D + col + 128, v1 + b1); }
};
struct JobPle {
    static constexpr int K = KP, KMID = 256, MAXU = 64 * 4, LDA = KP, LDB = KP;
    Ctx c; __device__ JobPle(const Ctx& c_) : c(c_) {}
    __device__ bool unit(int idx, Unit& u, const bf16_t*& A, const bf16_t*& Bt) const {
        if (idx >= MAXU) return false; u.pm = idx % 64; u.pn = idx / 64; u.e = 0;
        A = c.ACAT2() + (size_t)u.pm * 256 * KP; Bt = c.WPLE() + (size_t)u.pn * 256 * KP; return true; }
    __device__ void mid(const Unit&, int row, int col, f32x4& v0, f32x4& v1) const {
        *(f32x4*)(c.V() + (size_t)row * D + col) = v0; *(f32x4*)(c.V() + (size_t)row * D + col + 128) = v1; v0 = (f32x4){0.f, 0.f, 0.f, 0.f}; v1 = v0; }
    __device__ void epi(const Unit&, int row, int col, f32x4 v0, f32x4 v1) const {
        float* vp = c.V() + (size_t)row * D + col; const float* xp = c.x2() + (size_t)row * D + col;
        f32x4 l0 = *(f32x4*)vp, l1 = *(f32x4*)(vp + 128); const f32x4 x0 = *(const f32x4*)xp, x1 = *(const f32x4*)(xp + 128);
        for (int j = 0; j < 4; ++j) { l0[j] = ALPHA * x0[j] + l0[j] * sigmoidf_(v0[j] + c.b_pg()[col + j]); l1[j] = ALPHA * x1[j] + l1[j] * sigmoidf_(v1[j] + c.b_pg()[col + 128 + j]); }
        *(f32x4*)vp = l0; *(f32x4*)(vp + 128) = l1; }
};

#if 0
template <class Job> __global__ void __launch_bounds__(256) sgemm_kernel(Params P, int layer) {
    __shared__ float As[16][129]; __shared__ float Bs[16][65];
    const Ctx c(P, layer); const Job J(c);
    const int idx = blockIdx.x >> 3, sub = blockIdx.x & 7, rh = sub >> 2, cs = sub & 3;
    Unit u; const bf16_t *A, *Bt; constexpr int lda = Job::LDA, ldb = Job::LDB;
    if (!J.unit(idx, u, A, Bt)) return;
    const int tid = threadIdx.x, cg = tid & 7, rg = tid >> 3;
    A += (size_t)rh * 128 * lda;
    f32x4 acc0[4], acc1[4];
    for (int i = 0; i < 4; ++i) { acc0[i] = (f32x4){0.f, 0.f, 0.f, 0.f}; acc1[i] = acc0[i]; }
    const int row0 = u.pm * 256 + rh * 128 + rg * 4, col0 = u.pn * 256 + cs * 32 + cg * 4;
    for (int k0 = 0; k0 < Job::K; k0 += 16) {
        if (Job::KMID > 0 && k0 == Job::KMID) { for (int i = 0; i < 4; ++i) J.mid(u, row0 + i, col0, acc0[i], acc1[i]); }
        { const int r = tid >> 1, kq = (tid & 1) * 8; const u32x4 v = *(const u32x4*)(A + (size_t)r * lda + k0 + kq);
          for (int j = 0; j < 4; ++j) { As[kq + 2 * j][r] = __uint_as_float(v[j] << 16); As[kq + 2 * j + 1][r] = __uint_as_float(v[j] & 0xffff0000u); } }
        { const int jn = tid >> 2, kq = (tid & 3) * 4; const int n = (jn < 32) ? cs * 32 + jn : 128 + cs * 32 + (jn - 32);
          const u32x2 v = *(const u32x2*)(Bt + (size_t)n * ldb + k0 + kq);
          for (int j = 0; j < 2; ++j) { Bs[kq + 2 * j][jn] = __uint_as_float(v[j] << 16); Bs[kq + 2 * j + 1][jn] = __uint_as_float(v[j] & 0xffff0000u); } }
        __syncthreads();
#pragma unroll
        for (int k = 0; k < 16; ++k) {
            float a[4], b0[4], b1[4];
            for (int i = 0; i < 4; ++i) a[i] = As[k][rg * 4 + i];
            for (int j = 0; j < 4; ++j) { b0[j] = Bs[k][cg * 4 + j]; b1[j] = Bs[k][32 + cg * 4 + j]; }
            for (int i = 0; i < 4; ++i) for (int j = 0; j < 4; ++j) { acc0[i][j] += a[i] * b0[j]; acc1[i][j] += a[i] * b1[j]; }
        }
        __syncthreads();
    }
    for (int i = 0; i < 4; ++i) J.epi(u, row0 + i, col0, acc0[i], acc1[i]);
}

#endif

namespace pg8 {
#define PG8_LAS __attribute__((address_space(3)))
typedef short bf16x8 __attribute__((ext_vector_type(8)));
constexpr int BM = 256, BK = 64, HALF = 128, HTB = HALF * BK * 2, STAGE_BYTES = 8 * HTB;
__host__ __device__ __forceinline__ int lds_byte(int r, int c) { const int st = (r >> 4) * 2 + (c >> 5), rr = r & 15, cc = c & 31, ob = rr * 64 + cc * 2; return st * 1024 + (ob ^ (((ob >> 9) & 1) << 5)); }
__host__ __device__ __forceinline__ void stage_rc(int b, int& R, int& C) { const int st = b / 1024, sb = b % 1024, swz = sb ^ (((sb >> 9) & 1) << 5); R = (st >> 1) * 16 + swz / 64; C = (st & 1) * 32 + (swz % 64) / 2; }
__device__ __forceinline__ const char* uni_ptr(const void* p) { const unsigned long long v = (unsigned long long)p; const unsigned lo = __builtin_amdgcn_readfirstlane((unsigned)v), hi = __builtin_amdgcn_readfirstlane((unsigned)(v >> 32)); return (const char*)(((unsigned long long)hi << 32) | lo); }

template <class Job> __device__ __forceinline__ bool get_unit(const Job& J, int idx, Unit& u, const char*& a, const char*& b) {
    const bf16_t *A, *Bt; if (!J.unit(idx, u, A, Bt)) return false; a = uni_ptr(A); b = uni_ptr(Bt); return true; }
template <class Job> __device__ __forceinline__ void run_epi(const Job& J, const Unit& u, const f32x4 (&acc)[2][2][4][2], int wr, int wc, int fr, int fq) {
#pragma unroll
    for (int ai = 0; ai < 2; ++ai)
#pragma unroll
        for (int m = 0; m < 4; ++m) {
#pragma unroll
            for (int n = 0; n < 2; ++n) J.epi(u, u.pm * BM + ai * HALF + wr * 64 + m * 16 + fr, u.pn * BM + wc * 32 + n * 16 + fq * 4, acc[ai][0][m][n], acc[ai][1][m][n]);
            asm volatile("" ::: "memory"); }
}
template <class Job> __device__ __forceinline__ void run_mid(const Job& J, const Unit& u, f32x4 (&acc)[2][2][4][2], int wr, int wc, int fr, int fq) {
#pragma unroll
    for (int ai = 0; ai < 2; ++ai)
#pragma unroll
        for (int m = 0; m < 4; ++m) {
#pragma unroll
            for (int n = 0; n < 2; ++n) J.mid(u, u.pm * BM + ai * HALF + wr * 64 + m * 16 + fr, u.pn * BM + wc * 32 + n * 16 + fq * 4, acc[ai][0][m][n], acc[ai][1][m][n]);
            asm volatile("" ::: "memory"); }
}

template <class Job>
__device__ __forceinline__ void gemm_phase(PG8_LAS unsigned char* lds, const Job& J, const int c, const int G) {
    int tid_ = threadIdx.x; asm volatile("" : "+v"(tid_));
    const int tid = tid_, wid = __builtin_amdgcn_readfirstlane(tid >> 6), lane = tid & 63, wr = wid >> 2, wc = wid & 3, fr = lane & 15, fq = lane >> 4;
    constexpr int K = Job::K, nt = K / BK, LDA = Job::LDA, LDB = Job::LDB, TM = Job::KMID / BK;
    static_assert(K % 128 == 0 && K >= 256 && (TM % 2) == 0, "K-loop shape");
    unsigned voffA[2], voffB[2];
#pragma unroll
    for (int i = 0; i < 2; ++i) { int R, C; stage_rc(tid * 16 + i * 8192, R, C); voffA[i] = (unsigned)(R * LDA + C) * 2u; voffB[i] = (unsigned)(R * LDB + C) * 2u; }
    constexpr size_t kstep = (size_t)(BK * 2), hstepA = (size_t)HALF * LDA * 2, hstepB = (size_t)HALF * LDB * 2;
    const unsigned ldsw = (unsigned)wid * 1024u;
    const int aoff = lds_byte(wr * 64 + fr, fq * 8), boff = lds_byte(wc * 32 + fr, fq * 8);
#define PG8_SA(b, h) (((b) * 2 + (h)) * HTB)
#define PG8_SB(b, h) ((4 + (b) * 2 + (h)) * HTB)
#define PG8_STAGE(bufoff, gbase, voff) do { _Pragma("unroll") for (int _i = 0; _i < 2; ++_i) \
        __builtin_amdgcn_global_load_lds((const unsigned*)((const char*)(gbase) + (voff)[_i]), (PG8_LAS unsigned*)(lds + (bufoff) + ldsw + _i * 8192), 16, 0, 0); } while (0)
#define PG8_LDA(dst, b, h) do { _Pragma("unroll") for (int m = 0; m < 4; ++m) _Pragma("unroll") for (int k = 0; k < 2; ++k) dst[m][k] = *(const PG8_LAS bf16x8*)(lds + PG8_SA(b, h) + aoff + m * 2048 + k * 1024); } while (0)
#define PG8_LDB(dst, b, h) do { _Pragma("unroll") for (int n = 0; n < 2; ++n) _Pragma("unroll") for (int k = 0; k < 2; ++k) dst[n][k] = *(const PG8_LAS bf16x8*)(lds + PG8_SB(b, h) + boff + n * 2048 + k * 1024); } while (0)
#define PG8_MMA(ai, bj, At, Bt) do { __builtin_amdgcn_s_setprio(1); _Pragma("unroll") for (int m = 0; m < 4; ++m) _Pragma("unroll") for (int n = 0; n < 2; ++n) _Pragma("unroll") for (int k = 0; k < 2; ++k) \
        acc[ai][bj][m][n] = __builtin_amdgcn_mfma_f32_16x16x32_bf16(Bt[n][k], At[m][k], acc[ai][bj][m][n], 0, 0, 0); __builtin_amdgcn_s_setprio(0); } while (0)
#define PG8_WAIT_V(n) asm volatile("s_waitcnt vmcnt(" #n ")" ::: "memory")
#define PG8_WAIT_L(n) asm volatile("s_waitcnt lgkmcnt(" #n ")" ::: "memory")
#define PG8_BAR __builtin_amdgcn_s_barrier()
#define PG8_SCHED __builtin_amdgcn_sched_barrier(0)
    Unit cur, nxt; int ui = 0; const char *cA, *cB;
    if (!get_unit(J, c, cur, cA, cB)) return;
    f32x4 acc[2][2][4][2];
#pragma unroll
    for (int a = 0; a < 2; ++a)
#pragma unroll
        for (int b = 0; b < 2; ++b)
#pragma unroll
            for (int m = 0; m < 4; ++m)
#pragma unroll
                for (int n = 0; n < 2; ++n) acc[a][b][m][n] = (f32x4){0.f, 0.f, 0.f, 0.f};
    bf16x8 At[4][2], B0[2][2], B1[2][2];
    PG8_STAGE(PG8_SB(0, 0), cB, voffB); PG8_STAGE(PG8_SB(0, 1), cB + hstepB, voffB); PG8_STAGE(PG8_SA(0, 0), cA, voffA); PG8_STAGE(PG8_SA(0, 1), cA + hstepA, voffA);
    if (wr == 1) PG8_BAR;
    PG8_WAIT_V(2); PG8_BAR;
    PG8_STAGE(PG8_SB(1, 0), cB + kstep, voffB); PG8_STAGE(PG8_SA(1, 0), cA + kstep, voffA); PG8_STAGE(PG8_SB(1, 1), cB + hstepB + kstep, voffB);
    PG8_WAIT_V(6); PG8_BAR;
    for (;;) {
        const char *nA, *nB;
        const bool has_next = get_unit(J, (ui + 1) * G + c, nxt, nA, nB);
        if (!has_next) { nA = cA; nB = cB; }
#define PG8_KBODY(t, last) do { \
            const char* a1 = cA + (size_t)((t) + 1) * kstep; \
            const char* a2 = (last) ? nA : cA + (size_t)((t) + 2) * kstep; const char* b2 = (last) ? nB : cB + (size_t)((t) + 2) * kstep; \
            const char* a3 = a2 + kstep; const char* b3 = b2 + kstep; \
              \
            PG8_LDB(B0, 0, 0); PG8_LDB(B1, 0, 1); PG8_SCHED; PG8_LDA(At, 0, 0); PG8_STAGE(PG8_SA(1, 1), a1 + hstepA, voffA); \
            PG8_WAIT_V(8); PG8_WAIT_L(0); PG8_BAR; PG8_MMA(0, 0, At, B0); PG8_MMA(0, 1, At, B1); PG8_BAR; PG8_SCHED; \
              \
            PG8_LDA(At, 0, 1); PG8_STAGE(PG8_SB(0, 0), b2, voffB); PG8_STAGE(PG8_SB(0, 1), b2 + hstepB, voffB); PG8_STAGE(PG8_SA(0, 0), a2, voffA); \
            PG8_WAIT_V(8); PG8_WAIT_L(0); PG8_BAR; PG8_MMA(1, 0, At, B0); PG8_MMA(1, 1, At, B1); PG8_BAR; PG8_SCHED; \
              \
            PG8_LDB(B0, 1, 0); PG8_LDB(B1, 1, 1); PG8_SCHED; PG8_LDA(At, 1, 0); PG8_STAGE(PG8_SA(0, 1), a2 + hstepA, voffA); \
            PG8_WAIT_V(8); PG8_WAIT_L(0); PG8_BAR; PG8_MMA(0, 0, At, B0); PG8_MMA(0, 1, At, B1); PG8_BAR; PG8_SCHED; \
              \
            PG8_LDA(At, 1, 1); PG8_STAGE(PG8_SB(1, 0), b3, voffB); PG8_STAGE(PG8_SB(1, 1), b3 + hstepB, voffB); PG8_STAGE(PG8_SA(1, 0), a3, voffA); \
            PG8_WAIT_V(8); PG8_WAIT_L(0); PG8_BAR; PG8_MMA(1, 0, At, B0); PG8_MMA(1, 1, At, B1); PG8_BAR; PG8_SCHED; } while (0)
        if constexpr (TM > 0) {
#pragma unroll 1
            for (int t = 0; t < TM; t += 2) PG8_KBODY(t, false);
            run_mid(J, cur, acc, wr, wc, fr, fq); PG8_WAIT_V(0);
#pragma unroll 1
            for (int t = TM; t < nt; t += 2) PG8_KBODY(t, t == nt - 2);
        } else {
#pragma unroll 1
            for (int t = 0; t < nt; t += 2) PG8_KBODY(t, t == nt - 2);
        }
#undef PG8_KBODY
        if (wr == 0) PG8_BAR;
        run_epi(J, cur, acc, wr, wc, fr, fq);
        if (!has_next) break;
#pragma unroll
        for (int a = 0; a < 2; ++a)
#pragma unroll
            for (int b = 0; b < 2; ++b)
#pragma unroll
                for (int m = 0; m < 4; ++m)
#pragma unroll
                    for (int n = 0; n < 2; ++n) acc[a][b][m][n] = (f32x4){0.f, 0.f, 0.f, 0.f};
        cur = nxt; cA = nA; cB = nB; ++ui;
        if (wr == 1) PG8_BAR;
    }
    PG8_WAIT_V(0);
    PG8_BAR;
#undef PG8_SA
#undef PG8_SB
#undef PG8_STAGE
#undef PG8_LDA
#undef PG8_LDB
#undef PG8_MMA
#undef PG8_WAIT_V
#undef PG8_WAIT_L
#undef PG8_BAR
#undef PG8_SCHED
}
}
constexpr int LDS_BYTES = 147456;
#if 0
template <class Job> __global__ void __launch_bounds__(512, 2) mgemm_kernel(Params P, int layer) {
    extern __shared__ __attribute__((aligned(16))) unsigned char lds[];
    const Ctx c(P, layer); const Job J(c);
    pg8::gemm_phase<Job>((PG8_LAS unsigned char*)lds, J, (int)blockIdx.x, (int)gridDim.x);
}
#endif

__device__ __forceinline__ void phase_conv(const Ctx& c, int vb, int nb) {
    const int tid = tid_opaque();
    for (size_t i = (size_t)vb * blockDim.x + tid; i < (size_t)T * D / 4; i += (size_t)nb * blockDim.x) {
        const int t = (int)((4 * i) / D), ch = (int)((4 * i) % D), s = t % SEQ;
        f32x4 acc = *(const f32x4*)(c.conv_b() + ch);
#pragma unroll
        for (int w = 0; w < 4; ++w) { const int ss = s - 3 + w; if (ss < 0) continue;
            const u32x2 v = *(const u32x2*)(c.XR() + (size_t)(t - 3 + w) * D + ch); const f32x4 cw = *(const f32x4*)(c.conv_w() + w * D + ch);
            acc[0] += cw[0] * __uint_as_float(v.x << 16); acc[1] += cw[1] * __uint_as_float(v.x & 0xffff0000u);
            acc[2] += cw[2] * __uint_as_float(v.y << 16); acc[3] += cw[3] * __uint_as_float(v.y & 0xffff0000u); }
        u32x2 o; o.x = pk2(acc[0], acc[1]); o.y = pk2(acc[2], acc[3]); *(u32x2*)(c.XC() + (size_t)t * D + ch) = o;
    }
}
__device__ __forceinline__ void phase_attn_simple(const Ctx& c, int vb, int nb) {
    const int tid = tid_opaque();
    for (int i = vb * blockDim.x + tid; i < 3 * T * 8; i += nb * blockDim.x) {
        const int h = i & 7, sr = (i >> 3) % T, g = i / (8 * T);
        const int d = dil_of(g), L = SEQ / d, l = sr % L;
        const bf16_t* Q = c.QKV() + (size_t)(g * 3 + 0) * T * 512; const bf16_t* Kp = c.QKV() + (size_t)(g * 3 + 1) * T * 512; const bf16_t* Vp = c.QKV() + (size_t)(g * 3 + 2) * T * 512;
        float q[64], o[64];
        for (int j = 0; j < 64; ++j) { q[j] = bf2f(Q[(size_t)sr * 512 + h * 64 + j]); o[j] = 0.f; }
        float m = -INFINITY, sum = 0.f;
        const int lo = l - 128 < 0 ? 0 : l - 128;
        for (int lk = lo; lk <= l; ++lk) { const size_t kr = (size_t)(sr - l + lk) * 512 + h * 64;
            float s = 0.f; for (int j = 0; j < 64; ++j) s += q[j] * bf2f(Kp[kr + j]);
            const float mn = fmaxf(m, s), f = __expf(m - mn), pz = __expf(s - mn);
            sum = sum * f + pz; for (int j = 0; j < 64; ++j) o[j] = o[j] * f + pz * bf2f(Vp[kr + j]); m = mn; }
        const int tok = token_of_split(g, sr); const float inv = 1.f / sum;
        bf16_t* op = c.OG() + (size_t)g * T * 512 + (size_t)tok * 512 + h * 64;
        for (int j = 0; j < 64; j += 2) *(unsigned*)(op + j) = pk2(o[j] * inv, o[j + 1] * inv);
        c.LSE()[((size_t)g * T + tok) * 8 + h] = m + __logf(sum);
    }
}
typedef short bf16x8_t __attribute__((ext_vector_type(8)));
typedef short s16x4_t __attribute__((ext_vector_type(4)));
typedef float f32x16 __attribute__((ext_vector_type(16)));
typedef float f32x2_t __attribute__((ext_vector_type(2))); typedef __bf16 bf16x2_t __attribute__((ext_vector_type(2)));
__device__ __forceinline__ unsigned cvtpk(float lo, float hi) { f32x2_t v = {lo, hi}; bf16x2_t b = __builtin_convertvector(v, bf16x2_t); return __builtin_bit_cast(unsigned, b); }
__device__ __forceinline__ int crow(int r, int hi) { return (r & 3) + 8 * (r >> 2) + 4 * hi; }
__device__ __forceinline__ void phase_attn(const Ctx& c, LAS unsigned char* L, int vb, int nb) {
    const int tid = tid_opaque(), lane = tid & 63, wid = __builtin_amdgcn_readfirstlane(tid >> 6), hg = wid >> 2, w4 = wid & 3, r32 = lane & 31, hi = lane >> 5;
    LAS unsigned char* Vl = L + hg * 32768;
    LAS float* wsf = (LAS float*)(L + 65536 + wid * 256);
    const int gt = tid & 255;
    for (int u = vb; u < 1536; u += nb) {
        const int hp = u & 3, blk = (u >> 2) & 127, g = u >> 9, h = 2 * hp + hg;
        const int nbk = (SEQ >> (2 * g)) >> 7, n = blk & (nbk - 1);
        const bf16_t* Qg = c.QKV() + (size_t)(g * 3 + 0) * T * 512; const bf16_t* Kg = c.QKV() + (size_t)(g * 3 + 1) * T * 512; const bf16_t* Vg = c.QKV() + (size_t)(g * 3 + 2) * T * 512;
        const long krow0 = (long)128 * (blk - 1);
        for (int ps = (n == 0 ? 4 : 0); ps < 8; ++ps) { const int key = ps * 32 + (gt >> 3), ch = gt & 7, d0 = ch * 8;
            const u32x4 v = *(const u32x4*)(Vg + (size_t)(krow0 + key) * 512 + h * 64 + d0);
            *(LAS u32x4*)(Vl + (d0 >> 5) * 16384 + (key >> 4) * 1024 + (key & 15) * 64 + (d0 & 31) * 2) = v; }
        bf16x8_t qf[4];
        { const bf16_t* qp = Qg + (size_t)(128 * blk + 32 * w4 + r32) * 512 + h * 64 + 8 * hi;
#pragma unroll
          for (int d0 = 0; d0 < 4; ++d0) qf[d0] = *(const bf16x8_t*)(qp + 16 * d0); }
        const int t0 = (n == 0) ? (4 - w4) : 0;
        f32x16 p[5];
#pragma unroll
        for (int t = 0; t < 5; ++t) {
            if (t >= t0) {
                const bf16_t* kp = Kg + (size_t)(krow0 + 32 * (w4 + t) + r32) * 512 + h * 64 + 8 * hi;
                bf16x8_t kf[4];
#pragma unroll
                for (int d0 = 0; d0 < 4; ++d0) kf[d0] = *(const bf16x8_t*)(kp + 16 * d0);
                f32x16 a = {};
#pragma unroll
                for (int d0 = 0; d0 < 4; ++d0) a = __builtin_amdgcn_mfma_f32_32x32x16_bf16(kf[d0], qf[d0], a, 0, 0, 0);
                p[t] = a;
            } else {
#pragma unroll
                for (int r = 0; r < 16; ++r) p[t][r] = -INFINITY;
            }
        }
#pragma unroll
        for (int r = 0; r < 16; ++r) { const int x = crow(r, hi); if (x < r32) p[0][r] = -INFINITY; if (x > r32) p[4][r] = -INFINITY; }
        float m = -INFINITY;
#pragma unroll
        for (int t = 0; t < 5; ++t)
#pragma unroll
            for (int r = 0; r < 16; ++r) m = fmaxf(m, p[t][r]);
        m = fmaxf(m, __shfl_xor(m, 32));
        const float mb = m * 1.4426950408889634f; float sum = 0.f;
#pragma unroll
        for (int t = 0; t < 5; ++t)
#pragma unroll
            for (int r = 0; r < 16; ++r) { const float e = __builtin_amdgcn_exp2f(p[t][r] * 1.4426950408889634f - mb); p[t][r] = e; sum += e; }
        sum += __shfl_xor(sum, 32);
        const int qsr = 128 * blk + 32 * w4;
        if (hi == 0) { wsf[r32] = __builtin_amdgcn_rcpf(sum); c.LSE()[((size_t)g * T + token_of_split(g, qsr + r32)) * 8 + h] = m + __logf(sum); }
        __syncthreads();
        f32x16 o[2]; o[0] = (f32x16){}; o[1] = (f32x16){};
        const LAS unsigned char* vrd = Vl + ((lane >> 4) & 1) * 32 + (lane & 3) * 8 + (4 * hi + ((lane & 15) >> 2)) * 64;
#pragma unroll
        for (int t = 0; t < 5; ++t) {
            if (t >= t0) {
#pragma unroll
                for (int s = 0; s < 2; ++s) {
                    u32x4 pw; pw.x = cvtpk(p[t][8 * s + 0], p[t][8 * s + 1]); pw.y = cvtpk(p[t][8 * s + 2], p[t][8 * s + 3]); pw.z = cvtpk(p[t][8 * s + 4], p[t][8 * s + 5]); pw.w = cvtpk(p[t][8 * s + 6], p[t][8 * s + 7]);
                    const bf16x8_t pa = __builtin_bit_cast(bf16x8_t, pw);
                    const int gk = 2 * (w4 + t) + s;
#pragma unroll
                    for (int dh = 0; dh < 2; ++dh) {
                        const s16x4_t lo = __builtin_bit_cast(s16x4_t, __builtin_amdgcn_ds_read_tr16_b64_v4i16((LAS s16x4_t*)(vrd + dh * 16384 + gk * 1024)));
                        const s16x4_t hh = __builtin_bit_cast(s16x4_t, __builtin_amdgcn_ds_read_tr16_b64_v4i16((LAS s16x4_t*)(vrd + dh * 16384 + gk * 1024 + 512)));
                        const bf16x8_t vf = (bf16x8_t){lo[0], lo[1], lo[2], lo[3], hh[0], hh[1], hh[2], hh[3]};
                        o[dh] = __builtin_amdgcn_mfma_f32_32x32x16_bf16(pa, vf, o[dh], 0, 0, 0);
                    }
                }
            }
        }
        bf16_t* og = c.OG() + (size_t)g * T * 512 + h * 64 + r32;
#pragma unroll
        for (int r = 0; r < 16; ++r) { const int qi = crow(r, hi); const float rl = wsf[qi]; const size_t tok = (size_t)token_of_split(g, qsr + qi);
            og[tok * 512] = (bf16_t)f2bf(o[0][r] * rl); og[tok * 512 + 32] = (bf16_t)f2bf(o[1][r] * rl); }
        __syncthreads();
    }
}
__device__ __forceinline__ void phase_scan1(const Ctx& c, int vb, int nb) {
    const int tid = tid_opaque();
    for (int u = vb; u < NB * 64 * 2; u += nb) {
        const int half = u & 1, seg = (u >> 1) & 63, b = u >> 7; const int ch = half * 512 + tid;
        const size_t base = ((size_t)b * SEQ + seg * 64) * D + ch; float P = 1.f, h = 0.f;
#pragma unroll 8
        for (int s = 0; s < 64; ++s) { const float a = c.AA()[base + (size_t)s * D], bx = c.BX()[base + (size_t)s * D]; h = a * h + bx; P *= a; c.AA()[base + (size_t)s * D] = P; c.BX()[base + (size_t)s * D] = h; }
        float* sg = c.SEGS() + (((size_t)b * 64 + seg) * D + ch) * 2; sg[0] = P; sg[1] = h;
    }
}
__device__ __forceinline__ void phase_attn_mix(const Ctx& c, int vb, int nb) {
    const int tid = tid_opaque();
    for (size_t i = (size_t)vb * blockDim.x + tid; i < (size_t)T * 512 / 4; i += (size_t)nb * blockDim.x) {
        const int t = (int)((4 * i) / 512), col = (int)((4 * i) % 512), h = col >> 6;
        const float l0 = c.LSE()[((size_t)0 * T + t) * 8 + h], l1 = c.LSE()[((size_t)1 * T + t) * 8 + h], l2 = c.LSE()[((size_t)2 * T + t) * 8 + h];
        const float m = fmaxf(l0, fmaxf(l1, l2)); float w0 = __expf(l0 - m), w1 = __expf(l1 - m), w2 = __expf(l2 - m); const float inv = 1.f / (w0 + w1 + w2); w0 *= inv; w1 *= inv; w2 *= inv;
        const u32x2 a = *(const u32x2*)(c.OG() + (size_t)0 * T * 512 + (size_t)t * 512 + col), b = *(const u32x2*)(c.OG() + (size_t)1 * T * 512 + (size_t)t * 512 + col), d = *(const u32x2*)(c.OG() + (size_t)2 * T * 512 + (size_t)t * 512 + col);
        f32x4 o;
        o[0] = w0 * __uint_as_float(a.x << 16) + w1 * __uint_as_float(b.x << 16) + w2 * __uint_as_float(d.x << 16);
        o[1] = w0 * __uint_as_float(a.x & 0xffff0000u) + w1 * __uint_as_float(b.x & 0xffff0000u) + w2 * __uint_as_float(d.x & 0xffff0000u);
        o[2] = w0 * __uint_as_float(a.y << 16) + w1 * __uint_as_float(b.y << 16) + w2 * __uint_as_float(d.y << 16);
        o[3] = w0 * __uint_as_float(a.y & 0xffff0000u) + w1 * __uint_as_float(b.y & 0xffff0000u) + w2 * __uint_as_float(d.y & 0xffff0000u);
        u32x2 r; r.x = pk2(o[0], o[1]); r.y = pk2(o[2], o[3]); *(u32x2*)(c.ACAT() + (size_t)t * KC + 1024 + col) = r;
    }
}
__device__ __forceinline__ void phase_scan2(const Ctx& c, int vb, int nb) {
    const int tid = tid_opaque();
    for (int u = vb; u < NB * 64 * 2; u += nb) {
        const int half = u & 1, seg = (u >> 1) & 63, b = u >> 7; const int ch = half * 512 + tid;
        float carry = 0.f;
        for (int s = 0; s < seg; ++s) { const float* sg = c.SEGS() + (((size_t)b * 64 + s) * D + ch) * 2; carry = sg[0] * carry + sg[1]; }
        const size_t t0 = (size_t)b * SEQ + seg * 64;
#pragma unroll 8
        for (int s = 0; s < 64; ++s) { const size_t o = (t0 + s) * D + ch; const float h = c.BX()[o] + c.AA()[o] * carry;
            c.ACAT()[(t0 + s) * KC + ch] = (bf16_t)f2bf(bf2f(c.GYR()[o]) * h); }
    }
}
__device__ __forceinline__ void ln_row(f32x4 (&v)[4], const float* g, const float* b, int lane) {
    float s = 0.f;
#pragma unroll
    for (int j = 0; j < 4; ++j) s += (v[j][0] + v[j][1]) + (v[j][2] + v[j][3]);
    const float mean = wave_sum(s) * (1.f / D); float s2 = 0.f;
#pragma unroll
    for (int j = 0; j < 4; ++j) { v[j] = v[j] - mean; s2 += (v[j][0] * v[j][0] + v[j][1] * v[j][1]) + (v[j][2] * v[j][2] + v[j][3] * v[j][3]); }
    const float rstd = 1.f / sqrtf(wave_sum(s2) * (1.f / D) + LN_EPS);
#pragma unroll
    for (int j = 0; j < 4; ++j) { const f32x4 gg = *(const f32x4*)(g + 4 * lane + 256 * j), bb = *(const f32x4*)(b + 4 * lane + 256 * j); v[j] = v[j] * rstd * gg + bb; }
}
__device__ __forceinline__ void phase_ln1_router(const Ctx& c, float* scr, int vb, int nb) {
    const int tid = tid_opaque();
    const int lane = tid & 63, wave = tid >> 6, nwv = blockDim.x >> 6;
    for (int t = vb * nwv + wave; t < T; t += nb * nwv) {
        f32x4 v[4];
#pragma unroll
        for (int j = 0; j < 4; ++j) v[j] = *(const f32x4*)(c.V() + (size_t)t * D + 4 * lane + 256 * j);
        ln_row(v, c.ln1g(), c.ln1b(), lane);
#pragma unroll
        for (int j = 0; j < 4; ++j) *(f32x4*)(c.x1() + (size_t)t * D + 4 * lane + 256 * j) = v[j];
        float* rowl = scr + wave * D;
#pragma unroll
        for (int j = 0; j < 4; ++j) *(f32x4*)(rowl + 4 * lane + 256 * j) = v[j];
        float lg[32];
#pragma unroll
        for (int e = 0; e < 32; ++e) lg[e] = 0.f;
        const f32x4* wr = (const f32x4*)(c.w_router() + (size_t)lane * NE);
#pragma unroll 2
        for (int kk = 0; kk < 16; ++kk) { const float xv = rowl[kk * 64 + lane];
#pragma unroll
            for (int e4 = 0; e4 < 8; ++e4) { const f32x4 w = wr[e4]; lg[4 * e4] += xv * w[0]; lg[4 * e4 + 1] += xv * w[1]; lg[4 * e4 + 2] += xv * w[2]; lg[4 * e4 + 3] += xv * w[3]; }
            wr += 64 * NE / 4; }
#pragma unroll
        for (int e = 0; e < 32; ++e) lg[e] = wave_sum(lg[e]) + c.b_router()[e];
        int te[4]; float tv[4]; unsigned used = 0u;
#pragma unroll
        for (int k = 0; k < 4; ++k) { float best = -INFINITY; int bi = 0;
#pragma unroll
            for (int e = 0; e < 32; ++e) { const bool ok = !((used >> e) & 1u) && lg[e] > best; best = ok ? lg[e] : best; bi = ok ? e : bi; }
            te[k] = bi; tv[k] = best; used |= 1u << bi; }
        const float e1 = __expf(tv[1] - tv[0]), e2 = __expf(tv[2] - tv[0]), e3 = __expf(tv[3] - tv[0]); const float inv = 1.f / (1.f + e1 + e2 + e3);
        if (lane < 4) { const float gk = (lane == 0 ? 1.f : lane == 1 ? e1 : lane == 2 ? e2 : e3) * inv; const int ek = lane == 0 ? te[0] : lane == 1 ? te[1] : lane == 2 ? te[2] : te[3];
            c.TOPE()[t * 4 + lane] = ek; c.TOPG()[t * 4 + lane] = gk; atomicAdd(&c.CNT()[ek], 1u); }
    }
}
__device__ __forceinline__ void phase_scatter(const Ctx& c, int vb, int nb) {
    const int tid = tid_opaque();
    const int lane = tid & 63, wave = tid >> 6, nwv = blockDim.x >> 6;
    for (int t = vb * nwv + wave; t < T; t += nb * nwv) {
        int slot = 0;
        if (lane < 4) { const int e = c.TOPE()[t * 4 + lane]; int base = 0; for (int i = 0; i < e; ++i) base += (int)((c.CNT()[i] + 255u) & ~255u);
            slot = base + (int)atomicAdd(&c.CUR()[e], 1u); c.SLOT()[t * 4 + lane] = slot; }
        u32x2 o[4];
#pragma unroll
        for (int j = 0; j < 4; ++j) { const f32x4 v = *(const f32x4*)(c.x1() + (size_t)t * D + 4 * lane + 256 * j); o[j].x = pk2(v[0], v[1]); o[j].y = pk2(v[2], v[3]); }
#pragma unroll
        for (int k = 0; k < 4; ++k) { const int sl = __shfl(slot, k);
#pragma unroll
            for (int j = 0; j < 4; ++j) *(u32x2*)(c.XG() + (size_t)sl * D + 4 * lane + 256 * j) = o[j]; }
    }
}
__device__ __forceinline__ void phase_combine_ln2(const Ctx& c, int vb, int nb) {
    const int tid = tid_opaque();
    const int lane = tid & 63, wave = tid >> 6, nwv = blockDim.x >> 6;
    for (int t = vb * nwv + wave; t < T; t += nb * nwv) {
        f32x4 v[4];
#pragma unroll
        for (int j = 0; j < 4; ++j) v[j] = *(const f32x4*)(c.x1() + (size_t)t * D + 4 * lane + 256 * j) * ALPHA;
#pragma unroll
        for (int k = 0; k < 4; ++k) { const int sl = c.SLOT()[t * 4 + k]; const float gk = c.TOPG()[t * 4 + k];
#pragma unroll
            for (int j = 0; j < 4; ++j) { const u32x2 y = *(const u32x2*)(c.YB() + (size_t)sl * D + 4 * lane + 256 * j);
                v[j][0] += gk * __uint_as_float(y.x << 16); v[j][1] += gk * __uint_as_float(y.x & 0xffff0000u); v[j][2] += gk * __uint_as_float(y.y << 16); v[j][3] += gk * __uint_as_float(y.y & 0xffff0000u); } }
        ln_row(v, c.ln2g(), c.ln2b(), lane);
#pragma unroll
        for (int j = 0; j < 4; ++j) { *(f32x4*)(c.x2() + (size_t)t * D + 4 * lane + 256 * j) = v[j]; u32x2 o; o.x = pk2(v[j][0], v[j][1]); o.y = pk2(v[j][2], v[j][3]);
            *(u32x2*)(c.ACAT2() + (size_t)t * KP + 256 + 4 * lane + 256 * j) = o; }
    }
}
__device__ __forceinline__ void phase_ln3(const Ctx& c, int vb, int nb) {
    const int tid = tid_opaque();
    const int lane = tid & 63, wave = tid >> 6, nwv = blockDim.x >> 6;
    for (int t = vb * nwv + wave; t < T; t += nb * nwv) {
        f32x4 v[4];
#pragma unroll
        for (int j = 0; j < 4; ++j) v[j] = *(const f32x4*)(c.V() + (size_t)t * D + 4 * lane + 256 * j);
        ln_row(v, c.ln3g(), c.ln3b(), lane);
#pragma unroll
        for (int j = 0; j < 4; ++j) { *(f32x4*)(c.x3() + (size_t)t * D + 4 * lane + 256 * j) = v[j]; u32x2 o; o.x = pk2(v[j][0], v[j][1]); o.y = pk2(v[j][2], v[j][3]);
            *(u32x2*)(c.XBF() + (size_t)t * D + 4 * lane + 256 * j) = o; }
    }
}


#define XB_TMO      128
#define XB_XCNT(j)  (256  + 64 * (j))
#define XB_XSUB(j)  (1280 + 64 * (j))
#define XB_XGEN(j)  (2304 + 64 * (j))
#define XB_TOP      3328
#define XB_TOPGEN   3392
#define XCD_BAR_WORDS 3456
#define XB_SPIN_CAP (1u << 18)
__device__ __forceinline__ unsigned xb_ld(unsigned* p)              { return __hip_atomic_load(p, __ATOMIC_RELAXED, __HIP_MEMORY_SCOPE_AGENT); }
__device__ __forceinline__ unsigned xb_add(unsigned* p, unsigned v) { return __hip_atomic_fetch_add(p, v, __ATOMIC_RELAXED, __HIP_MEMORY_SCOPE_AGENT); }
__device__ __forceinline__ unsigned xb_xcc_id() { return (unsigned)__builtin_amdgcn_s_getreg((3 << 11) | 20) & 0xFu; }
#define XB_SPIN(cond, bar) do { unsigned _sp = 0; while (cond) { __builtin_amdgcn_s_sleep(1); \
    if ((++_sp & 255u) == 0u) { if (xb_ld(&(bar)[XB_TMO])) break; if (_sp > XB_SPIN_CAP) { atomicAdd(&(bar)[XB_TMO], 1u); break; } } } } while (0)
struct XcdBarrier { unsigned* bar; unsigned x; volatile LAS unsigned* st; };
__device__ __forceinline__ XcdBarrier xcd_barrier_post(unsigned* bar, volatile LAS unsigned* st) {
    XcdBarrier b; b.bar = bar; b.x = xb_xcc_id(); b.st = st;
    if (threadIdx.x == 0) (void)xb_add(&bar[XB_XCNT(b.x)], 1u);
    return b;
}
__device__ __forceinline__ void xcd_barrier_complete(unsigned* bar, unsigned x, unsigned& nloc, unsigned& nx) {
    const unsigned G = gridDim.x * gridDim.y * gridDim.z;
    unsigned sum, cnt, mine, sp = 0u;
    for (;;) {
        sum = 0u; cnt = 0u; mine = 0u;
#pragma unroll
        for (unsigned j = 0; j < 16; ++j) { const unsigned c = xb_ld(&bar[XB_XCNT(j)]); sum += c; cnt += (c > 0u) ? 1u : 0u; mine = (j == x) ? c : mine; }
        if (sum == G) break;
        __builtin_amdgcn_s_sleep(1);
        if ((++sp & 255u) == 0u) { if (xb_ld(&bar[XB_TMO])) break; if (sp > XB_SPIN_CAP) { atomicAdd(&bar[XB_TMO], 1u); break; } }
    }
    nloc = mine > 0u ? mine : 1u; nx = cnt > 0u ? cnt : 1u;
}
__device__ __forceinline__ void xcd_barrier(const XcdBarrier& b) {
    asm volatile("s_waitcnt vmcnt(0)" ::: "memory");
    __syncthreads();
    if (threadIdx.x == 0) {
        unsigned* bar = b.bar; asm volatile("" : "+s"(bar));
        __builtin_amdgcn_s_waitcnt(0);
        unsigned nloc = b.st[0], nx = b.st[1];
        if (nloc == 0u) { xcd_barrier_complete(bar, b.x, nloc, nx); b.st[0] = nloc; b.st[1] = nx; }
        const unsigned old = xb_add(&bar[XB_XSUB(b.x)], 1u);
        const unsigned gen = old / nloc;
        if (old + 1u == (gen + 1u) * nloc) {
            __builtin_amdgcn_fence(__ATOMIC_RELEASE, "agent");
            asm volatile("s_waitcnt vmcnt(0)" ::: "memory");
            const unsigned og = xb_add(&bar[XB_TOP], 1u);
            const unsigned tg = og / nx;
            if (og + 1u == (tg + 1u) * nx) xb_add(&bar[XB_TOPGEN], 1u);
            else XB_SPIN(xb_ld(&bar[XB_TOPGEN]) == tg, bar);
            __builtin_amdgcn_fence(__ATOMIC_ACQUIRE, "agent");
            xb_add(&bar[XB_XGEN(b.x)], 1u);
            asm volatile("s_waitcnt vmcnt(0)" ::: "memory");
        } else {
            XB_SPIN(xb_ld(&bar[XB_XGEN(b.x)]) == gen, bar);
            __builtin_amdgcn_fence(__ATOMIC_ACQUIRE, "agent");
            asm volatile("s_waitcnt vmcnt(0)" ::: "memory");
        }
    }
    __syncthreads();
}
constexpr int CW_BAR = 4096;
constexpr int RING_BYTES = 131072, LDSCTL_OFF = RING_BYTES, MISC_OFF = LDSCTL_OFF + 320;

__global__ void __launch_bounds__(512, 2) mega_kernel(Params P) {
    extern __shared__ __attribute__((aligned(16))) unsigned char lds[];
    LAS unsigned char* L = (LAS unsigned char*)lds;
    for (int u = threadIdx.x; u < (LDS_BYTES - LDSCTL_OFF) / 4; u += 512) ((LAS unsigned*)(L + LDSCTL_OFF))[u] = 0u;
    __syncthreads();
    const XcdBarrier bar = xcd_barrier_post((unsigned*)(P.ws + WS_CTL) + CW_BAR, (volatile LAS unsigned*)(L + MISC_OFF) + 8);
    const int vb = blockIdx.x, nb = gridDim.x;
#define GRID_BAR() xcd_barrier(bar)
#define LAYER_BODY(l) do { \
        { const Ctx c(l); phase_convert(c, (float*)lds, vb, nb); } GRID_BAR(); \
        { const Ctx c(l); const JobInproj J(c); pg8::gemm_phase<JobInproj>(L, J, vb, nb); } GRID_BAR(); \
        { const Ctx c(l); phase_conv(c, vb, nb); } { const Ctx c(l); phase_attn(c, L, vb, nb); } GRID_BAR(); \
        { const Ctx c(l); const JobGate J(c); pg8::gemm_phase<JobGate>(L, J, vb, nb); } GRID_BAR(); \
        { const Ctx c(l); phase_scan1(c, vb, nb); } { const Ctx c(l); phase_attn_mix(c, vb, nb); } GRID_BAR(); \
        { const Ctx c(l); phase_scan2(c, vb, nb); } GRID_BAR(); \
        { const Ctx c(l); const JobY J(c); pg8::gemm_phase<JobY>(L, J, vb, nb); } GRID_BAR(); \
        { const Ctx c(l); const JobOut J(c); pg8::gemm_phase<JobOut>(L, J, vb, nb); } GRID_BAR(); \
        { const Ctx c(l); phase_ln1_router(c, (float*)lds, vb, nb); } GRID_BAR(); \
        { const Ctx c(l); phase_scatter(c, vb, nb); } GRID_BAR(); \
        { const Ctx c(l); const JobMoeGU J(c); pg8::gemm_phase<JobMoeGU>(L, J, vb, nb); } GRID_BAR(); \
        { const Ctx c(l); const JobMoeD J(c); pg8::gemm_phase<JobMoeD>(L, J, vb, nb); } GRID_BAR(); \
        { const Ctx c(l); phase_combine_ln2(c, vb, nb); } GRID_BAR(); \
        { const Ctx c(l); const JobPle J(c); pg8::gemm_phase<JobPle>(L, J, vb, nb); } GRID_BAR(); \
        { const Ctx c(l); phase_ln3(c, vb, nb); } if (l == 0) GRID_BAR(); \
 \
    } while (0)
    LAYER_BODY(0);
    LAYER_BODY(1);
#undef LAYER_BODY
}

#if 0
template <int PH> __global__ void __launch_bounds__(512) ew_kernel(Params P, int layer) {
    __shared__ float scr[8 * 64 * 33];
    const Ctx c(P, layer); const int vb = blockIdx.x, nb = gridDim.x;
    if (PH == 0) phase_convert(c, scr, vb, nb);
    else if (PH == 1) phase_conv(c, vb, nb);
    else if (PH == 2) phase_attn_simple(c, vb, nb);
    else if (PH == 3) phase_scan1(c, vb, nb);
    else if (PH == 4) phase_attn_mix(c, vb, nb);
    else if (PH == 5) phase_scan2(c, vb, nb);
    else if (PH == 6) phase_ln1_router(c, (float*)lds, vb, nb);
    else if (PH == 7) phase_scatter(c, vb, nb);
    else if (PH == 8) phase_combine_ln2(c, vb, nb);
    else if (PH == 9) phase_ln3(c, vb, nb);
}

#endif
extern "C" void kernel_launch(void* const* d_in, const int* in_sizes, int n_in, void* d_out, int out_size, void* d_ws, size_t ws_size, hipStream_t stream) {
    static int grid = 0;
    if (grid == 0) {
        if (n_in != 30 || ws_size < WS_END) { fprintf(stderr, "kernel_launch: unexpected n_in %d or ws_size %zu\n", n_in, ws_size); grid = -1; return; }
        int dev = 0, cus = 0;
        if (hipGetDevice(&dev) != hipSuccess || hipDeviceGetAttribute(&cus, hipDeviceAttributeMultiprocessorCount, dev) != hipSuccess) { grid = -1; return; }
        if (hipFuncSetAttribute((const void*)mega_kernel, hipFuncAttributeMaxDynamicSharedMemorySize, LDS_BYTES) != hipSuccess) { fprintf(stderr, "kernel_launch: hipFuncSetAttribute failed\n"); grid = -1; return; }
        grid = cus;
    }
    if (grid < 0) return;
    Params P{}; for (int i = 0; i < 30; ++i) P.in[i] = (const float*)d_in[i]; P.out = (float*)d_out; P.ws = (unsigned char*)d_ws;
    (void)hipMemsetAsync((char*)d_ws + WS_CTL, 0, CTL_BYTES, stream);
    hipLaunchKernelGGL(mega_kernel, dim3(grid), dim3(512), LDS_BYTES, stream, P);
}
```
